# Optimizing an MI355X kernel written in HIP

```python
import math
import jax, jax.numpy as jnp
from jax import lax
import numpy as np


D_MODEL = 1024
BATCH = 16
SEQ = 2048
DEPTH = 1
DEC_BATCH = 32
DEC_SEQ = 32
PAST_LEN = 2048

CHUNK = 64
D_MIX = 2 * D_MODEL
W_POOL = D_MIX // 2
W_MLSTM = D_MIX - W_POOL
POOL_WINDOWS = (2, 4, 8, 16)
N_POOL_GROUPS = 4
POOL_GW = W_POOL // N_POOL_GROUPS
POOL_BUF = 15
N_HEADS = 4
HEAD_DIM = W_MLSTM // N_HEADS
EPS = 1e-6
IN_SECTIONS = (W_POOL, W_POOL, W_MLSTM, W_MLSTM, W_MLSTM, W_MLSTM, W_MLSTM, N_HEADS, N_HEADS)
D_IN = 2 * W_POOL + 5 * W_MLSTM + 2 * N_HEADS

kernel_name = 'hybrid_pool_mlstm_streaming_step'


def _split_points():
    pts, acc = [], 0
    for s in IN_SECTIONS[:-1]:
        acc += s
        pts.append(acc)
    return pts


def rmsnorm(x, g):
    xf = x.astype(jnp.float32)
    r = lax.rsqrt(jnp.mean(xf * xf, axis=-1, keepdims=True) + EPS)
    return (xf * r).astype(x.dtype) * g


def head_layernorm(h):
    mu = jnp.mean(h, axis=-1, keepdims=True)
    hc = h - mu
    out = hc * lax.rsqrt(jnp.mean(hc * hc, axis=-1, keepdims=True) + EPS)
    B, H, T, Dh = h.shape
    return out.transpose(0, 2, 1, 3).reshape(B, T, H * Dh)


def pool_mixer(xp, buf, start, w_pool, pool_scale):
    B, T, W = xp.shape
    ext = jnp.concatenate([buf, xp], axis=1).astype(jnp.float32)
    cs = jnp.cumsum(ext, axis=1)
    cs = jnp.concatenate([jnp.zeros((B, 1, W), jnp.float32), cs], axis=1)
    top = cs[:, POOL_BUF + 1:POOL_BUF + 1 + T]
    pos = jnp.arange(T) + start
    means = []
    for g, w in enumerate(POOL_WINDOWS):
        sl = slice(g * POOL_GW, (g + 1) * POOL_GW)
        win = top[..., sl] - cs[:, POOL_BUF + 1 - w:POOL_BUF + 1 - w + T, sl]
        cnt = jnp.minimum(pos + 1, w).astype(jnp.float32)
        means.append(win / cnt[None, :, None])
    pooled = jnp.concatenate(means, axis=-1) - xp.astype(jnp.float32)
    pooled = pooled.astype(xp.dtype).reshape(B, T, N_POOL_GROUPS, POOL_GW)
    mixed = jnp.einsum('btgc,gcd->btgd', pooled, w_pool).reshape(B, T, W)
    return mixed * pool_scale


def mlstm_block(carry, blk):
    C0, n0, m0 = carry
    q, k, v, ig, lf = blk
    L = q.shape[2]
    F = jnp.cumsum(lf, axis=-1)
    a = ig - F
    m = F + jnp.maximum(m0[..., None], lax.cummax(a, axis=a.ndim - 1))
    causal = jnp.tril(jnp.ones((L, L), dtype=bool))
    logD = F[..., :, None] + a[..., None, :] - m[..., :, None]
    D = jnp.exp(jnp.where(causal, logD, -jnp.inf))
    decay0 = jnp.exp(m0[..., None] + F - m)
    S = jnp.einsum('bhtd,bhsd->bhts', q, k) * D
    num = jnp.einsum('bhts,bhsd->bhtd', S, v) + decay0[..., None] * jnp.einsum('bhtk,bhkv->bhtv', q, C0)
    nq = jnp.sum(S, axis=-1) + decay0 * jnp.einsum('bhtk,bhk->bht', q, n0)
    h = num / jnp.maximum(jnp.abs(nq), jnp.exp(-m))[..., None]
    mL = m[..., -1]
    wL = jnp.exp(a + F[..., -1:] - mL[..., None])
    dL = jnp.exp(m0 + F[..., -1] - mL)
    C = dL[..., None, None] * C0 + jnp.einsum('bhs,bhsk,bhsv->bhkv', wL, k, v)
    n = dL[..., None] * n0 + jnp.einsum('bhs,bhsk->bhk', wL, k)
    return (C, n, mL), h


def mlstm_sequence(q, k, v, ig, lf, C0, n0, m0):
    B, H, T, Dh = q.shape
    L = min(T, CHUNK)
    NB = T // L

    def blocks(t):
        return jnp.moveaxis(t.reshape(t.shape[:2] + (NB, L) + t.shape[3:]), 2, 0)

    carry0 = (C0.astype(jnp.float32), n0.astype(jnp.float32), m0.astype(jnp.float32))
    carry, hs = lax.scan(mlstm_block, carry0, (blocks(q), blocks(k), blocks(v), blocks(ig), blocks(lf)))
    h = jnp.moveaxis(hs, 0, 2).reshape(B, H, T, Dh)
    return h, carry


def mixer_layer(x, c, pool_buf, C0, n0, m0, start, w_ada, b_ada, g_norm, w_in, b_i, b_f,
                w_pool, pool_scale, g_head, w_out):
    B, T, _ = x.shape
    mod = jnp.einsum('bd,de->be', jax.nn.silu(c), w_ada) + b_ada
    shift, scale, gate = jnp.split(mod[:, None, :], 3, axis=-1)
    h = rmsnorm(x, g_norm) * (1 + scale) + shift
    u = jnp.einsum('btd,de->bte', h, w_in)
    xp, zp, q, k, v, o, zm, ig, fg = jnp.split(u, _split_points(), axis=-1)
    y_pool = pool_mixer(xp, pool_buf, start, w_pool, pool_scale) * jax.nn.silu(zp)
    new_buf = jnp.concatenate([pool_buf, xp], axis=1)[:, -POOL_BUF:]
    def heads(t):
        return t.reshape(B, T, N_HEADS, HEAD_DIM).transpose(0, 2, 1, 3).astype(jnp.float32)
    qh = heads(q)
    kh = heads(k) * (HEAD_DIM ** -0.5)
    vh = heads(v)
    igh = (ig + b_i).astype(jnp.float32).transpose(0, 2, 1)
    lfh = jax.nn.log_sigmoid((fg + b_f).astype(jnp.float32)).transpose(0, 2, 1)
    hm, (C1, n1, m1) = mlstm_sequence(qh, kh, vh, igh, lfh, C0, n0, m0)
    hm = head_layernorm(hm).astype(x.dtype) * g_head
    y_m = hm * jax.nn.sigmoid(o) * jax.nn.silu(zm)
    y = jnp.einsum('bte,ed->btd', jnp.concatenate([y_pool, y_m], axis=-1), w_out)
    x = x + gate * y
    return x, new_buf, C1.astype(x.dtype), n1.astype(x.dtype), m1.astype(x.dtype)


def setup_inputs(seed: int = 0) -> dict:
    key = jax.random.key(seed)
    ks = jax.random.split(key, 24)
    nrm = jax.random.normal
    f32 = jnp.float32
    return {
        'x_prompt': nrm(ks[0], (BATCH, SEQ, D_MODEL), f32),
        'x_sample': nrm(ks[1], (DEC_BATCH, DEC_SEQ, D_MODEL), f32),
        'c_prompt': nrm(ks[2], (BATCH, D_MODEL), f32),
        'c_sample': nrm(ks[3], (DEC_BATCH, D_MODEL), f32),
        'state_pool': nrm(ks[4], (DEPTH, DEC_BATCH, POOL_BUF, W_POOL), f32),
        'state_C': 0.1 * nrm(ks[5], (DEPTH, DEC_BATCH, N_HEADS, HEAD_DIM, HEAD_DIM), f32),
        'state_n': 0.1 * nrm(ks[6], (DEPTH, DEC_BATCH, N_HEADS, HEAD_DIM), f32),
        'state_m': nrm(ks[7], (DEPTH, DEC_BATCH, N_HEADS), f32),
        'w_ada': 0.5 * nrm(ks[8], (DEPTH, D_MODEL, 3 * D_MODEL), f32) * D_MODEL ** -0.5,
        'b_ada': 0.01 * nrm(ks[9], (DEPTH, 3 * D_MODEL), f32),
        'g_norm': 1.0 + 0.02 * nrm(ks[10], (DEPTH, D_MODEL), f32),
        'w_in': nrm(ks[11], (DEPTH, D_MODEL, D_IN), f32) * D_MODEL ** -0.5,
        'b_i': 0.1 * nrm(ks[12], (DEPTH, N_HEADS), f32),
        'b_f': jnp.linspace(3.0, 6.0, N_HEADS, dtype=f32)[None, :] + 0.1 * nrm(ks[13], (DEPTH, N_HEADS), f32),
        'w_pool': nrm(ks[14], (DEPTH, N_POOL_GROUPS, POOL_GW, POOL_GW), f32) * POOL_GW ** -0.5,
        'pool_scale': 1.0 + 0.02 * nrm(ks[15], (DEPTH, W_POOL), f32),
        'g_head': 1.0 + 0.02 * nrm(ks[16], (DEPTH, W_MLSTM), f32),
        'w_out': nrm(ks[17], (DEPTH, D_MIX, D_MODEL), f32) * D_MIX ** -0.5,
        'g_final': 1.0 + 0.02 * nrm(ks[18], (D_MODEL,), f32),
    }


def reference(x_prompt, x_sample, c_prompt, c_sample, state_pool, state_C, state_n, state_m,
              w_ada, b_ada, g_norm, w_in, b_i, b_f, w_pool, pool_scale, g_head, w_out, g_final):
    xpr, xsm = x_prompt, x_sample
    dt = x_prompt.dtype
    pp, pc, pn, pm, sp, sc, sn, sm = [], [], [], [], [], [], [], []
    for l in range(DEPTH):
        lw = (w_ada[l], b_ada[l], g_norm[l], w_in[l], b_i[l], b_f[l], w_pool[l], pool_scale[l], g_head[l], w_out[l])
        zb = jnp.zeros((BATCH, POOL_BUF, W_POOL), dt)
        zC = jnp.zeros((BATCH, N_HEADS, HEAD_DIM, HEAD_DIM), dt)
        zn = jnp.zeros((BATCH, N_HEADS, HEAD_DIM), dt)
        zm = jnp.zeros((BATCH, N_HEADS), dt)
        xpr, b1, C1, n1, m1 = mixer_layer(xpr, c_prompt, zb, zC, zn, zm, 0, *lw)
        xsm, b2, C2, n2, m2 = mixer_layer(xsm, c_sample, state_pool[l], state_C[l], state_n[l], state_m[l],
                                          PAST_LEN, *lw)
        pp.append(b1); pc.append(C1); pn.append(n1); pm.append(m1)
        sp.append(b2); sc.append(C2); sn.append(n2); sm.append(m2)
    y_prompt = rmsnorm(xpr, g_final)
    y_sample = rmsnorm(xsm, g_final)
    return (y_prompt, y_sample, jnp.stack(pp), jnp.stack(pc), jnp.stack(pn), jnp.stack(pm),
            jnp.stack(sp), jnp.stack(sc), jnp.stack(sn), jnp.stack(sm))
```

```cpp
#include <hip/hip_runtime.h>
#include <hip/hip_cooperative_groups.h>
#include <cstdio>
#include <cstdint>
#ifndef PROBE_DUP
#define PROBE_DUP 0
#endif
namespace cg = cooperative_groups;

#define LAS __attribute__((address_space(3)))
typedef unsigned short bf16_t;
typedef short bf16x8 __attribute__((ext_vector_type(8)));
typedef float f32x4 __attribute__((ext_vector_type(4)));
typedef unsigned u32x4 __attribute__((ext_vector_type(4)));
typedef unsigned u32x2 __attribute__((ext_vector_type(2)));

constexpr int DM = 1024, NPB = 16, SEQ = 2048, NSB = 32, SSEQ = 32;
constexpr int MP = NPB * SEQ, MS = NSB * SSEQ, MT = MP + MS;
constexpr int LDU = 7168;
constexpr int C_XP = 0, C_ZP = 1024, C_ZM = 2048  , C_Q = 4096, C_K = 5120, C_V = 6144;
constexpr int WIN_LD = 7176;
constexpr float EPS = 1e-6f;
constexpr size_t O_Y = 0, O_PP = 34603008, O_CP = 34848768, O_NP = 39043072, O_MP = 39059456, O_PS = 39059520, O_CS = 39551040, O_NS = 47939648, O_MS = 47972416;
constexpr size_t MiB = 1u << 20;
constexpr size_t WS_U = 0, WS_WIN = 462 * MiB, WS_WOUT = 476 * MiB, WS_WPOOL = 480 * MiB, WS_MODP = 481 * MiB, WS_GATEF = 484 * MiB, WS_GATES = 485 * MiB, WS_CTL = 487 * MiB, WS_XBUF = 488 * MiB, WS_PART = 489 * MiB, WS_END = 505 * MiB;
constexpr int LDS_BYTES = 143360, L_MISC = 131072 + 2048, L_XP = 131072 + 4096, L_XS = L_XP + 4096;

struct Args { const float* in[19]; float* out; unsigned char* ws; };

__device__ __forceinline__ float bf2f(unsigned b) { return __uint_as_float(b << 16); }
__device__ __forceinline__ unsigned f2bf(float f) { unsigned u = __float_as_uint(f); return (u + 0x7fffu + ((u >> 16) & 1u)) >> 16; }
__device__ __forceinline__ unsigned pk2(float lo, float hi) { unsigned r; asm("v_cvt_pk_bf16_f32 %0, %1, %2" : "=v"(r) : "v"(lo), "v"(hi)); return r; }
__device__ __forceinline__ float wave_sum(float v) {
#pragma unroll
    for (int o = 1; o < 64; o <<= 1) v += __shfl_xor(v, o);
    return v;
}
__device__ __forceinline__ float sigmoidf_(float x) { return __builtin_amdgcn_rcpf(1.f + __builtin_amdgcn_exp2f(x * -1.44269504f)); }
__device__ __forceinline__ void unpack8(const u32x4 z, float (&o)[8]) {
    o[0] = bf2f(z.x & 0xffffu); o[1] = bf2f(z.x >> 16); o[2] = bf2f(z.y & 0xffffu); o[3] = bf2f(z.y >> 16); o[4] = bf2f(z.z & 0xffffu); o[5] = bf2f(z.z >> 16); o[6] = bf2f(z.w & 0xffffu); o[7] = bf2f(z.w >> 16);
}

namespace pg8 {
constexpr int BM = 256, BK = 64, HALF = 128, HTB = HALF * BK * 2, STAGE_BYTES = 8 * HTB, NXCD = 8, WGM = 8;
__host__ __device__ __forceinline__ int lds_byte(int r, int c) { const int st = (r >> 4) * 2 + (c >> 5), rr = r & 15, cc = c & 31, ob = rr * 64 + cc * 2; return st * 1024 + (ob ^ (((ob >> 9) & 1) << 5)); }
__host__ __device__ __forceinline__ void stage_rc(int b, int& R, int& C) { const int st = b / 1024, sb = b % 1024, swz = sb ^ (((sb >> 9) & 1) << 5); R = (st >> 1) * 16 + swz / 64; C = (st & 1) * 32 + (swz % 64) / 2; }
__host__ __device__ __forceinline__ int perm32(int rho) { const int n = rho >> 4, i = rho & 15; return 8 * (i >> 2) + 4 * n + (i & 3); }

struct Unit { int pm, pn, ao, bo, ks; };
struct Gemm { const bf16_t* A; const bf16_t* Bt; int M, N, K, lda, ldb, acol; };

struct StaticOrder {
    int nM, nN, nwg, G, c, acol;
    __device__ void init(int M, int N, int G_, int c_, int acol_ = 0) { nM = M / BM; nN = N / BM; nwg = nM * nN; G = G_; c = c_; acol = acol_; }
    __device__ bool next(int i, Unit& u) const {
        const long L = (long)i * G + c; if (L >= nwg) return false;
        int wgid = (int)L; { const int q = nwg / NXCD, r = nwg % NXCD, xcd = wgid % NXCD, off = wgid / NXCD; wgid = (xcd < r ? xcd * (q + 1) : r * (q + 1) + (xcd - r) * q) + off; }
        const int nig = WGM * nN, gid = wgid / nig, fm = gid * WGM, gsz = (nM - fm) < WGM ? (nM - fm) : WGM;
        u.pm = fm + ((wgid % nig) % gsz); u.pn = (wgid % nig) / gsz; u.ao = u.pn * acol; u.bo = 0; u.ks = 0; return true;
    }
};


struct PanelOrder {
    int c;
    __device__ bool next(int i, Unit& u) const { if (i >= 2) return false; const int x = c & 7, j = c >> 3; u.pm = 64 * i + 8 * x + (j >> 2); u.pn = j & 3; u.ao = 0; u.bo = 0; u.ks = 0; return true; }
};
struct PoolOrder {
    int c;
    __device__ bool next(int i, Unit& u) const {
        if (i < 2) { const int x = c & 7, j = c >> 3; u.pm = 64 * i + 8 * x + (j >> 2); u.pn = j & 3; }
        else if (i == 2 && (c & 15) == 0) { const int k = c >> 4; u.pm = 128 + (k >> 2); u.pn = k & 3; }
        else return false;
        u.ao = u.pn * 256; u.bo = 0; u.ks = 0; return true; }
};
struct SampleOrder {
    int c;
    __device__ bool next(int i, Unit& u) const { if (i >= 1 || c >= 64) return false; u.pm = 128 + (c & 3); u.pn = (c >> 2) & 3; u.ks = c >> 4; u.ao = u.ks * 512; u.bo = u.ks * 512; return true; }
};

struct EpiBf16 {
    bf16_t* O; int ldc, gm_lo, gm_hi, silu_lo, silu_hi;
    __device__ __forceinline__ void operator()(f32x4 (&acc)[2][2][4][2], const Unit& u, int wr, int wc, int fr, int fq, LAS unsigned char* lds) const {
        int t_ = threadIdx.x; asm volatile("" : "+v"(t_)); fr = t_ & 15; fq = (t_ >> 4) & 3;
        const int row0 = u.pm * BM + wr * 64 + fr; const int col0 = u.pn * BM + wc * 32 + 8 * fq;
#pragma unroll
        for (int ai = 0; ai < 2; ++ai)
#pragma unroll
            for (int m = 0; m < 4; ++m) { bf16_t* rowp = O + (size_t)(row0 + ai * HALF + m * 16) * ldc + col0;
#pragma unroll
                for (int bj = 0; bj < 2; ++bj) { const f32x4 v0 = acc[ai][bj][m][0], v1 = acc[ai][bj][m][1];
                    if (gm_lo <= u.pn && u.pn < gm_hi) {
                        float gmv[4];
#pragma unroll
                        for (int i = 0; i < 4; ++i) gmv[i] = sigmoidf_(v0[i]) * v1[i] * sigmoidf_(v1[i]);
                        *(u32x2*)(O + (size_t)(row0 + ai * HALF + m * 16) * ldc + gm_lo * BM + ((col0 + bj * HALF - gm_lo * BM) >> 1)) = (u32x2){pk2(gmv[0], gmv[1]), pk2(gmv[2], gmv[3])};
                    } else {
                    f32x4 s0 = v0, s1 = v1;
                    if (silu_lo <= u.pn && u.pn < silu_hi) {
#pragma unroll
                        for (int i = 0; i < 4; ++i) { s0[i] = v0[i] * sigmoidf_(v0[i]); s1[i] = v1[i] * sigmoidf_(v1[i]); } }
                    u32x4 w; w.x = pk2(s0[0], s0[1]); w.y = pk2(s0[2], s0[3]); w.z = pk2(s1[0], s1[1]); w.w = pk2(s1[2], s1[3]);
                    *(u32x4*)(rowp + bj * HALF) = w; } } }
    }
};
struct EpiPool {
    bf16_t* U; const float* pscale; bf16_t* dry;
    __device__ __forceinline__ void operator()(f32x4 (&acc)[2][2][4][2], const Unit& u, int wr, int wc, int fr, int fq, LAS unsigned char* lds) const {
        int t_ = threadIdx.x; asm volatile("" : "+v"(t_)); fr = t_ & 15; fq = (t_ >> 4) & 3;
        const int row0 = u.pm * BM + wr * 64 + fr; const int col0 = u.pn * BM + wc * 32 + 8 * fq;
        f32x4 ps[2][2];
#pragma unroll
        for (int bj = 0; bj < 2; ++bj) { ps[bj][0] = *(const f32x4*)(pscale + col0 + bj * HALF); ps[bj][1] = *(const f32x4*)(pscale + col0 + bj * HALF + 4); }
#pragma unroll
        for (int ai = 0; ai < 2; ++ai) {
            u32x4 zz[4][2];
#pragma unroll
            for (int m = 0; m < 4; ++m)
#pragma unroll
                for (int bj = 0; bj < 2; ++bj) zz[m][bj] = *(const u32x4*)(U + (size_t)(row0 + ai * HALF + m * 16) * LDU + C_ZP + col0 + bj * HALF);
#pragma unroll
            for (int m = 0; m < 4; ++m) { bf16_t* rowp = U + (size_t)(row0 + ai * HALF + m * 16) * LDU + C_ZP + col0;
#pragma unroll
                for (int bj = 0; bj < 2; ++bj) {
                    const f32x4 v0 = acc[ai][bj][m][0] * ps[bj][0], v1 = acc[ai][bj][m][1] * ps[bj][1];
                    float zf[8]; unpack8(zz[m][bj], zf);
                    float y[8];
#pragma unroll
                    for (int i = 0; i < 4; ++i) { y[i] = v0[i] * zf[i]; y[4 + i] = v1[i] * zf[4 + i]; }
                    u32x4 w; w.x = pk2(y[0], y[1]); w.y = pk2(y[2], y[3]); w.z = pk2(y[4], y[5]); w.w = pk2(y[6], y[7]);
                    *(u32x4*)(rowp + bj * HALF) = w; } }
        }
    }
};
struct EpiResLN {
    const float* xp; const float* gatef; const float* gfin; float* out; float* xbuf; unsigned* flags;
    __device__ __forceinline__ void operator()(f32x4 (&acc)[2][2][4][2], const Unit& u, int wr, int wc, int fr, int fq, LAS unsigned char* lds) const {
        int t_ = threadIdx.x; asm volatile("" : "+v"(t_)); fr = t_ & 15; fq = (t_ >> 4) & 3;
        const int row0 = u.pm * BM + wr * 64 + fr; const int col0 = u.pn * BM + wc * 32 + 8 * fq;
        LAS float* P = (LAS float*)(lds + L_XP); LAS float* S = (LAS float*)(lds + L_XS);
        {
            const float* gr = gatef + (u.pm >> 3) * DM + col0;
            f32x4 gv[2][2];
#pragma unroll
            for (int bj = 0; bj < 2; ++bj) { gv[bj][0] = *(const f32x4*)(gr + bj * HALF); gv[bj][1] = *(const f32x4*)(gr + bj * HALF + 4); }
#pragma unroll
            for (int ai = 0; ai < 2; ++ai)
#pragma unroll
                for (int m = 0; m < 4; ++m) { int rr_ = row0 + ai * HALF + m * 16; asm volatile("" : "+v"(rr_)); const float* xr = xp + (size_t)rr_ * DM + col0;
                    float sq = 0.f;
#pragma unroll
                    for (int bj = 0; bj < 2; ++bj) { const f32x4 v0 = *(const f32x4*)(xr + bj * HALF) + gv[bj][0] * acc[ai][bj][m][0], v1 = *(const f32x4*)(xr + bj * HALF + 4) + gv[bj][1] * acc[ai][bj][m][1];
                        acc[ai][bj][m][0] = v0; acc[ai][bj][m][1] = v1;
                        sq += ((v0[0] * v0[0] + v0[1] * v0[1]) + (v0[2] * v0[2] + v0[3] * v0[3])) + ((v1[0] * v1[0] + v1[1] * v1[1]) + (v1[2] * v1[2] + v1[3] * v1[3])); }
                    sq += __shfl_xor(sq, 16); sq += __shfl_xor(sq, 32);
                    if (fq == 0) P[(ai * HALF + wr * 64 + m * 16 + fr) * 4 + wc] = sq; }
        }
        __syncthreads();
        if (t_ < 256) { const f32x4 p4 = *(const LAS f32x4*)(P + t_ * 4);
            __hip_atomic_store(xbuf + (size_t)(u.pm * 4 + u.pn) * 256 + t_, (p4[0] + p4[1]) + (p4[2] + p4[3]), __ATOMIC_RELAXED, __HIP_MEMORY_SCOPE_AGENT); }
        asm volatile("s_waitcnt vmcnt(0)" ::: "memory");
        __syncthreads();
        if (t_ == 0) { unsigned* f = flags + u.pm * 16;
            (void)__hip_atomic_fetch_add(f, 1u, __ATOMIC_RELAXED, __HIP_MEMORY_SCOPE_AGENT);
            unsigned sp = 0u;
            while (__hip_atomic_load(f, __ATOMIC_RELAXED, __HIP_MEMORY_SCOPE_AGENT) < 4u) { __builtin_amdgcn_s_sleep(1); if (++sp > (1u << 22)) break; }
            __builtin_amdgcn_fence(__ATOMIC_ACQUIRE, "agent");
            asm volatile("s_waitcnt vmcnt(0)" ::: "memory"); }
        __syncthreads();
        if (t_ < 256) { float tot = 0.f;
#pragma unroll
            for (int q = 0; q < 4; ++q) tot += __hip_atomic_load(xbuf + (size_t)(u.pm * 4 + q) * 256 + t_, __ATOMIC_RELAXED, __HIP_MEMORY_SCOPE_AGENT);
            S[t_] = rsqrtf(tot * (1.f / DM) + EPS); }
        __syncthreads();
        {
            f32x4 gf[2][2];
#pragma unroll
            for (int bj = 0; bj < 2; ++bj) { gf[bj][0] = *(const f32x4*)(gfin + col0 + bj * HALF); gf[bj][1] = *(const f32x4*)(gfin + col0 + bj * HALF + 4); }
#pragma unroll
            for (int ai = 0; ai < 2; ++ai)
#pragma unroll
                for (int m = 0; m < 4; ++m) { const float rs = S[ai * HALF + wr * 64 + m * 16 + fr]; int rr_ = row0 + ai * HALF + m * 16; asm volatile("" : "+v"(rr_)); float* orow = out + (size_t)rr_ * DM + col0;
#pragma unroll
                    for (int bj = 0; bj < 2; ++bj) { *(f32x4*)(orow + bj * HALF) = acc[ai][bj][m][0] * rs * gf[bj][0]; *(f32x4*)(orow + bj * HALF + 4) = acc[ai][bj][m][1] * rs * gf[bj][1]; } }
        }
    }
};
struct EpiPart {
    float* part;
    __device__ __forceinline__ void operator()(f32x4 (&acc)[2][2][4][2], const Unit& u, int wr, int wc, int fr, int fq, LAS unsigned char* lds) const {
        int t_ = threadIdx.x; asm volatile("" : "+v"(t_)); fr = t_ & 15; fq = (t_ >> 4) & 3;
        const int row0 = u.pm * BM + wr * 64 + fr - MP; const int col0 = u.pn * BM + wc * 32 + 8 * fq;
#pragma unroll
        for (int ai = 0; ai < 2; ++ai)
#pragma unroll
            for (int m = 0; m < 4; ++m) { float* orow = part + ((size_t)u.ks * MS + row0 + ai * HALF + m * 16) * DM + col0;
#pragma unroll
                for (int bj = 0; bj < 2; ++bj) { *(f32x4*)(orow + bj * HALF) = acc[ai][bj][m][0]; *(f32x4*)(orow + bj * HALF + 4) = acc[ai][bj][m][1]; } }
    }
};

template <class Epi, class Sched, bool ALIGN_EPI, bool SP2>
__device__ __forceinline__ void gemm_phase(LAS unsigned char* lds, const Gemm g, const Sched& S, const Epi& E) {
    int tid = threadIdx.x; asm volatile("" : "+v"(tid));
    const int wid = __builtin_amdgcn_readfirstlane(tid >> 6), lane = tid & 63, wr = wid >> 2, wc = wid & 3, fr = lane & 15, fq = lane >> 4;
    const int K = g.K, nt = K / BK, lda = g.lda;
    unsigned voffA[2], voffB[2];
#pragma unroll
    for (int i = 0; i < 2; ++i) { int R, C; stage_rc(tid * 16 + i * 8192, R, C); const int Rb = (R & ~31) + perm32(R & 31);
        voffA[i] = (unsigned)(R * lda + C) * 2u; voffB[i] = (unsigned)(Rb * g.ldb + C) * 2u; }
    const size_t kstep = (size_t)(BK * 2);
    const size_t hstepA = (size_t)HALF * lda * 2, hstepB = (size_t)HALF * g.ldb * 2;
    const size_t tstepA = 2 * hstepA, tstepB = 2 * hstepB;
    const unsigned ldsw = (unsigned)wid * 1024u;
    const int aoff = lds_byte(wr * 64 + fr, fq * 8), boff = lds_byte(wc * 32 + fr, fq * 8);
#define PG8_SA(b, h) (((b) * 2 + (h)) * HTB)
#define PG8_SB(b, h) ((4 + (b) * 2 + (h)) * HTB)
#define PG8_STAGE(bufoff, gbase, voff) do { _Pragma("unroll") for (int _i = 0; _i < 2; ++_i) \
        __builtin_amdgcn_global_load_lds((const unsigned*)((const char*)(gbase) + (voff)[_i]), (LAS unsigned*)(lds + (bufoff) + ldsw + _i * 8192), 16, 0, 0); } while (0)
#define PG8_LDA(dst, b, h) do { _Pragma("unroll") for (int m = 0; m < 4; ++m) _Pragma("unroll") for (int k = 0; k < 2; ++k) dst[m][k] = *(const LAS bf16x8*)(lds + PG8_SA(b, h) + aoff + m * 2048 + k * 1024); } while (0)
#define PG8_LDB(dst, b, h) do { _Pragma("unroll") for (int n = 0; n < 2; ++n) _Pragma("unroll") for (int k = 0; k < 2; ++k) dst[n][k] = *(const LAS bf16x8*)(lds + PG8_SB(b, h) + boff + n * 2048 + k * 1024); } while (0)
#define PG8_MMA(ai, bj, At, Bt) do { __builtin_amdgcn_s_setprio(1); _Pragma("unroll") for (int m = 0; m < 4; ++m) _Pragma("unroll") for (int n = 0; n < 2; ++n) _Pragma("unroll") for (int k = 0; k < 2; ++k) \
        acc[ai][bj][m][n] = __builtin_amdgcn_mfma_f32_16x16x32_bf16(Bt[n][k], At[m][k], acc[ai][bj][m][n], 0, 0, 0); __builtin_amdgcn_s_setprio(0); } while (0)
#define PG8_WAIT_V(n) asm volatile("s_waitcnt vmcnt(" #n ")" ::: "memory")
#define PG8_WAIT_L(n) asm volatile("s_waitcnt lgkmcnt(" #n ")" ::: "memory")
#define PG8_BAR __builtin_amdgcn_s_barrier()
#define PG8_SCHED __builtin_amdgcn_sched_barrier(0)
    Unit cur, nxt; int ui = 0;
    if (!S.next(0, cur)) return;
    f32x4 acc[2][2][4][2];
#pragma unroll
    for (int a = 0; a < 2; ++a)
#pragma unroll
        for (int b = 0; b < 2; ++b)
#pragma unroll
            for (int m = 0; m < 4; ++m)
#pragma unroll
                for (int n = 0; n < 2; ++n) acc[a][b][m][n] = (f32x4){0.f, 0.f, 0.f, 0.f};
    bf16x8 At[4][2], B0[2][2], B1[2][2];
    const char* cA = (const char*)g.A + (size_t)cur.pm * tstepA + (size_t)cur.ao * 2; const char* cB = (const char*)g.Bt + (size_t)cur.pn * tstepB + (size_t)cur.bo * 2;
    if constexpr (SP2) {
        PG8_STAGE(PG8_SB(0, 0), cB, voffB); PG8_STAGE(PG8_SB(0, 1), cB + hstepB, voffB); PG8_STAGE(PG8_SA(0, 0), cA, voffA); PG8_STAGE(PG8_SA(0, 1), cA + hstepA, voffA);
        if (wr == 1) PG8_BAR;
        PG8_WAIT_V(2); PG8_BAR;
        PG8_STAGE(PG8_SB(1, 0), cB + kstep, voffB); PG8_STAGE(PG8_SA(1, 0), cA + kstep, voffA); PG8_STAGE(PG8_SB(1, 1), cB + hstepB + kstep, voffB);
        PG8_WAIT_V(6); PG8_BAR;
    } else {
        PG8_STAGE(PG8_SB(0, 0), cB, voffB); PG8_STAGE(PG8_SA(0, 0), cA, voffA); PG8_STAGE(PG8_SB(0, 1), cB + hstepB, voffB); PG8_STAGE(PG8_SA(0, 1), cA + hstepA, voffA);
        if (wr == 1) PG8_BAR;
        PG8_WAIT_V(4); PG8_BAR;
        PG8_STAGE(PG8_SB(1, 0), cB + kstep, voffB); PG8_STAGE(PG8_SA(1, 0), cA + kstep, voffA); PG8_STAGE(PG8_SB(1, 1), cB + hstepB + kstep, voffB);
        PG8_WAIT_V(6); PG8_BAR;
    }
    for (;;) {
        const bool has_next = S.next(ui + 1, nxt);
        const char* nA = has_next ? (const char*)g.A + (size_t)nxt.pm * tstepA + (size_t)nxt.ao * 2 : cA; const char* nB = has_next ? (const char*)g.Bt + (size_t)nxt.pn * tstepB + (size_t)nxt.bo * 2 : cB;
        for (int t = 0; t < nt; t += 2) {
            const bool last = (t == nt - 2);
            const char* a1 = cA + (size_t)(t + 1) * kstep;
            const char* a2 = last ? nA : cA + (size_t)(t + 2) * kstep; const char* b2 = last ? nB : cB + (size_t)(t + 2) * kstep;
            const char* a3 = a2 + kstep; const char* b3 = b2 + kstep;
            if constexpr (SP2) {
            PG8_LDB(B0, 0, 0); PG8_LDB(B1, 0, 1); PG8_SCHED; PG8_LDA(At, 0, 0); PG8_STAGE(PG8_SA(1, 1), a1 + hstepA, voffA);
            PG8_WAIT_V(8); PG8_WAIT_L(0); PG8_BAR; PG8_MMA(0, 0, At, B0); PG8_MMA(0, 1, At, B1); PG8_BAR; PG8_SCHED;
            PG8_LDA(At, 0, 1); PG8_STAGE(PG8_SB(0, 0), b2, voffB); PG8_STAGE(PG8_SB(0, 1), b2 + hstepB, voffB); PG8_STAGE(PG8_SA(0, 0), a2, voffA);
            PG8_WAIT_V(8); PG8_WAIT_L(0); PG8_BAR; PG8_MMA(1, 0, At, B0); PG8_MMA(1, 1, At, B1); PG8_BAR; PG8_SCHED;
            PG8_LDB(B0, 1, 0); PG8_LDB(B1, 1, 1); PG8_SCHED; PG8_LDA(At, 1, 0); PG8_STAGE(PG8_SA(0, 1), a2 + hstepA, voffA);
            PG8_WAIT_V(8); PG8_WAIT_L(0); PG8_BAR; PG8_MMA(0, 0, At, B0); PG8_MMA(0, 1, At, B1); PG8_BAR; PG8_SCHED;
            PG8_LDA(At, 1, 1); PG8_STAGE(PG8_SB(1, 0), b3, voffB); PG8_STAGE(PG8_SB(1, 1), b3 + hstepB, voffB); PG8_STAGE(PG8_SA(1, 0), a3, voffA);
            PG8_WAIT_V(8); PG8_WAIT_L(0); PG8_BAR; PG8_MMA(1, 0, At, B0); PG8_MMA(1, 1, At, B1); PG8_BAR; PG8_SCHED;
            } else {
            PG8_LDB(B0, 0, 0); PG8_SCHED; PG8_LDA(At, 0, 0); PG8_STAGE(PG8_SA(1, 1), a1 + hstepA, voffA);
            PG8_WAIT_L(8); PG8_BAR; PG8_WAIT_L(0); PG8_MMA(0, 0, At, B0); PG8_BAR; PG8_SCHED;
            PG8_LDB(B1, 0, 1); PG8_STAGE(PG8_SB(0, 0), b2, voffB);
            PG8_BAR; PG8_WAIT_L(0); PG8_MMA(0, 1, At, B1); PG8_BAR;
            PG8_LDA(At, 0, 1); PG8_STAGE(PG8_SA(0, 0), a2, voffA);
            PG8_BAR; PG8_WAIT_L(0); PG8_MMA(1, 0, At, B0); PG8_BAR; PG8_SCHED;
            PG8_STAGE(PG8_SB(0, 1), b2 + hstepB, voffB);
            PG8_WAIT_V(6); PG8_BAR; PG8_MMA(1, 1, At, B1); PG8_BAR;
            PG8_LDB(B0, 1, 0); PG8_SCHED; PG8_LDA(At, 1, 0); PG8_STAGE(PG8_SA(0, 1), a2 + hstepA, voffA);
            PG8_WAIT_L(8); PG8_BAR; PG8_WAIT_L(0); PG8_MMA(0, 0, At, B0); PG8_BAR; PG8_SCHED;
            PG8_LDB(B1, 1, 1); PG8_STAGE(PG8_SB(1, 0), b3, voffB);
            PG8_BAR; PG8_WAIT_L(0); PG8_MMA(0, 1, At, B1); PG8_BAR;
            PG8_LDA(At, 1, 1); PG8_STAGE(PG8_SA(1, 0), a3, voffA);
            PG8_BAR; PG8_WAIT_L(0); PG8_MMA(1, 0, At, B0); PG8_BAR; PG8_SCHED;
            PG8_STAGE(PG8_SB(1, 1), b3 + hstepB, voffB);
            PG8_WAIT_V(6); PG8_BAR; PG8_MMA(1, 1, At, B1); PG8_BAR;
            }
        }
        if constexpr (ALIGN_EPI) { if (wr == 0) PG8_BAR; }
        E(acc, cur, wr, wc, fr, fq, lds);
        if (!has_next) break;
#pragma unroll
        for (int a = 0; a < 2; ++a)
#pragma unroll
            for (int b = 0; b < 2; ++b)
#pragma unroll
                for (int m = 0; m < 4; ++m)
#pragma unroll
                    for (int n = 0; n < 2; ++n) acc[a][b][m][n] = (f32x4){0.f, 0.f, 0.f, 0.f};
        cur = nxt; cA = nA; cB = nB; ++ui;
        if constexpr (ALIGN_EPI) { if (wr == 1) PG8_BAR; }
    }
    PG8_WAIT_V(0);
    if constexpr (!ALIGN_EPI) { if (wr == 0) PG8_BAR; }
    PG8_BAR;
#undef PG8_SA
#undef PG8_SB
#undef PG8_STAGE
#undef PG8_LDA
#undef PG8_LDB
#undef PG8_MMA
#undef PG8_WAIT_V
#undef PG8_WAIT_L
#undef PG8_BAR
#undef PG8_SCHED
}
}

#define MFMA16(a, b, c) __builtin_amdgcn_mfma_f32_16x16x32_bf16((a), (b), (c), 0, 0, 0)

__device__ __forceinline__ void transpose_item(const float* W, int ldw, int scol  , bf16_t* WT, int Kd, int drow, int k0, float scale, LAS float* scr, int lane) {
#pragma unroll
    for (int i = 0; i < 32; ++i) { const int kk = 2 * i + (lane >> 5); scr[kk * 33 + (lane & 31)] = W[(size_t)(k0 + kk) * ldw + scol]; }
    asm volatile("s_waitcnt lgkmcnt(0)" ::: "memory");
    const int c = lane & 7;
#pragma unroll
    for (int j = 0; j < 4; ++j) { const int n = (lane >> 3) + 8 * j; const LAS float* s = scr + (8 * c) * 33 + n;
        u32x4 o; o.x = pk2(s[0 * 33] * scale, s[1 * 33] * scale); o.y = pk2(s[2 * 33] * scale, s[3 * 33] * scale); o.z = pk2(s[4 * 33] * scale, s[5 * 33] * scale); o.w = pk2(s[6 * 33] * scale, s[7 * 33] * scale);
        *(u32x4*)(WT + (size_t)(drow + n) * Kd + k0 + 8 * c) = o; }
    asm volatile("s_waitcnt lgkmcnt(0)" ::: "memory");
}

#define OPAQUE_TID() int tid = threadIdx.x; asm volatile("" : "+v"(tid)); const int lane = tid & 63, wave = __builtin_amdgcn_readfirstlane(tid >> 6); (void)lane; (void)wave
__device__ __forceinline__ void phase0(const Args& a, LAS unsigned char* L) {
    OPAQUE_TID();
    const int bid = blockIdx.x, G = gridDim.x;
    float* modp = (float*)(a.ws + WS_MODP);
    for (int item = bid; item < 192; item += G) {
        const int cc = item >> 2, kq = item & 3;
        LAS float* sC = (LAS float*)L;
        {
            const int kk = tid & 255, rh = tid >> 8;
            float cp[8], cs[16];
            const float* p0 = a.in[2] + (size_t)rh * DM + kq * 256 + kk; const float* p1 = a.in[3] + (size_t)rh * DM + kq * 256 + kk;
#pragma unroll
            for (int n = 0; n < 8; ++n) cp[n] = p0[(size_t)(2 * n) * DM];
#pragma unroll
            for (int n = 0; n < 16; ++n) cs[n] = p1[(size_t)(2 * n) * DM];
#pragma unroll
            for (int n = 0; n < 8; ++n) sC[kk * 48 + rh + 2 * n] = cp[n] * sigmoidf_(cp[n]);
#pragma unroll
            for (int n = 0; n < 16; ++n) sC[kk * 48 + 16 + rh + 2 * n] = cs[n] * sigmoidf_(cs[n]);
        }
        __syncthreads();
        float acc[48];
#pragma unroll
        for (int r = 0; r < 48; ++r) acc[r] = 0.f;
        const float* wp = a.in[8] + (size_t)(kq * 256 + wave * 32) * 3072 + cc * 64 + lane;
#pragma unroll 16
        for (int i = 0; i < 32; ++i) {
            const float w = wp[(size_t)i * 3072];
            const LAS f32x4* s4 = (const LAS f32x4*)(sC + (wave * 32 + i) * 48);
#pragma unroll
            for (int r4 = 0; r4 < 12; ++r4) { const f32x4 s = s4[r4]; acc[4 * r4 + 0] += s[0] * w; acc[4 * r4 + 1] += s[1] * w; acc[4 * r4 + 2] += s[2] * w; acc[4 * r4 + 3] += s[3] * w; }
        }
        __syncthreads();
        LAS float* red = (LAS float*)L;
#pragma unroll
        for (int r = 0; r < 48; ++r) red[(wave * 48 + r) * 64 + lane] = acc[r];
        __syncthreads();
        for (int o = tid; o < 3072; o += 512) { float s = 0.f;
#pragma unroll
            for (int w8 = 0; w8 < 8; ++w8) s += red[w8 * 3072 + o];
            modp[(size_t)(kq * 48 + (o >> 6)) * 3072 + cc * 64 + (o & 63)] = s; }
        __syncthreads();
    }
    LAS float* scr = (LAS float*)(L + wave * 16384);
    bf16_t* Win = (bf16_t*)(a.ws + WS_WIN); bf16_t* Wout = (bf16_t*)(a.ws + WS_WOUT); bf16_t* Wpool = (bf16_t*)(a.ws + WS_WPOOL);
    const int gw = bid * 8 + wave, NGW = G * 8;
    constexpr int I_IN = 16 * 224, I_OUT = 32 * 32, I_POOL = 128;
    for (int it = gw; it < I_IN + I_OUT + I_POOL; it += NGW) {
        int r = it;
        if (r < I_IN) { const int kb = r / 224, nb = r - kb * 224, n0 = nb * 32, n = n0 + (lane & 31), sec = n0 >> 10;
            int scol;
            if (sec < 2) scol = n;
            else if (sec < 4) { const int d = n - 2048, q = d >> 3, rr = d & 7; scol = (rr < 4 ? 5120 : 6144) + 4 * q + (rr & 3); }
            else scol = n - 2048;
            transpose_item(a.in[11], WIN_LD, scol, Win, 1024, n0, kb * 64, sec == 5 ? 0.0625f : 1.f, scr, lane); continue; }
        r -= I_IN;
        if (r < I_OUT) { const int kb = r >> 5, nb = r & 31; transpose_item(a.in[17], 1024, nb * 32 + (lane & 31), Wout, 2048, nb * 32, kb * 64, 1.f, scr, lane); continue; }
        r -= I_OUT;
        { const int gi = r >> 5, q = r & 31, kb = q >> 3, nb = q & 7; transpose_item(a.in[14] + (size_t)gi * 65536, 256, nb * 32 + (lane & 31), Wpool, 256, gi * 256 + nb * 32, kb * 64, 1.f, scr, lane); }
    }
}

__device__ __forceinline__ void phase1(const Args& a, LAS unsigned char* L) {
    OPAQUE_TID();
    const int bid = blockIdx.x, G = gridDim.x;
    const float* modp = (const float*)(a.ws + WS_MODP); const float* bada = a.in[9];
    float* gatef = (float*)(a.ws + WS_GATEF); float* gates = (float*)(a.ws + WS_GATES);
    bf16_t* HB = (bf16_t*)a.out;
    for (int r = bid; r < 48; r += G)
        for (int c = tid; c < DM; c += 512) { float s = bada[2048 + c];
#pragma unroll
            for (int q = 0; q < 4; ++q) s += modp[(size_t)(q * 48 + r) * 3072 + 2048 + c];
            gatef[r * DM + c] = s; }
    LAS f32x4* wg = (LAS f32x4*)L;
    for (int e = tid; e < 2048; e += 512) { const int ln = e & 63, q = e >> 6, half = q & 1, ji = q >> 1, k = 4 * ln + 256 * (ji >> 2) + (ji & 3);
        wg[e] = *(const f32x4*)(a.in[11] + (size_t)k * WIN_LD + 7168 + half * 4); }
    __syncthreads();
    const int gw = bid * 8 + wave;
    constexpr int RPW = 17;
    int m_lo = gw * RPW, m_hi = m_lo + RPW; if (m_hi > MT) m_hi = MT;
    int curb = -1; f32x4 gsv[4], shv[4];
#pragma unroll
    for (int j = 0; j < 4; ++j) { gsv[j] = (f32x4){0.f, 0.f, 0.f, 0.f}; shv[j] = gsv[j]; }
    f32x4 nxv[4], nxw[4];
#pragma unroll
    for (int j = 0; j < 4; ++j) { nxv[j] = (f32x4){0.f, 0.f, 0.f, 0.f}; nxw[j] = nxv[j]; }
    if (m_lo < m_hi) { const float* xr = (m_lo < MP ? a.in[0] + (size_t)m_lo * DM : a.in[1] + (size_t)(m_lo - MP) * DM);
#pragma unroll
        for (int j = 0; j < 4; ++j) nxv[j] = *(const f32x4*)(xr + 4 * lane + 256 * j); }
    if (m_lo + 1 < m_hi) { const int m1 = m_lo + 1; const float* xr = (m1 < MP ? a.in[0] + (size_t)m1 * DM : a.in[1] + (size_t)(m1 - MP) * DM);
#pragma unroll
        for (int j = 0; j < 4; ++j) nxw[j] = *(const f32x4*)(xr + 4 * lane + 256 * j); }
    for (int m = m_lo; m < m_hi; ++m) {
        const int b = m < MP ? (m >> 11) : 16 + ((m - MP) >> 5);
        if (b != curb) { curb = b;
#pragma unroll
            for (int j = 0; j < 4; ++j) { const int col = 4 * lane + 256 * j;
                f32x4 sh = *(const f32x4*)(bada + col), sc = *(const f32x4*)(bada + 1024 + col);
#pragma unroll
                for (int q = 0; q < 4; ++q) { sh += *(const f32x4*)(modp + (size_t)(q * 48 + b) * 3072 + col); sc += *(const f32x4*)(modp + (size_t)(q * 48 + b) * 3072 + 1024 + col); }
                const f32x4 gn = *(const f32x4*)(a.in[10] + col);
                gsv[j] = gn * (sc + 1.f); shv[j] = sh; } }
        f32x4 v[4]; float ss = 0.f;
#pragma unroll
        for (int j = 0; j < 4; ++j) { v[j] = nxv[j]; nxv[j] = nxw[j]; }
        if (m + 2 < m_hi) { const int m1 = m + 2; const float* xr = (m1 < MP ? a.in[0] + (size_t)m1 * DM : a.in[1] + (size_t)(m1 - MP) * DM);
#pragma unroll
            for (int j = 0; j < 4; ++j) nxw[j] = *(const f32x4*)(xr + 4 * lane + 256 * j); }
#pragma unroll
        for (int j = 0; j < 4; ++j) ss += (v[j][0] * v[j][0] + v[j][1] * v[j][1]) + (v[j][2] * v[j][2] + v[j][3] * v[j][3]);
        const float rr = rsqrtf(wave_sum(ss) * (1.f / DM) + EPS);
        float gacc[8];
#pragma unroll
        for (int q = 0; q < 8; ++q) gacc[q] = 0.f;
#pragma unroll
        for (int j = 0; j < 4; ++j) { const f32x4 h = v[j] * rr * gsv[j] + shv[j];
            *(u32x2*)(HB + (size_t)m * DM + 4 * lane + 256 * j) = (u32x2){pk2(h[0], h[1]), pk2(h[2], h[3])};
#pragma unroll
            for (int i = 0; i < 4; ++i) { const f32x4 w0 = wg[((j * 4 + i) * 2) * 64 + lane], w1 = wg[((j * 4 + i) * 2 + 1) * 64 + lane];
                gacc[0] += h[i] * w0[0]; gacc[1] += h[i] * w0[1]; gacc[2] += h[i] * w0[2]; gacc[3] += h[i] * w0[3];
                gacc[4] += h[i] * w1[0]; gacc[5] += h[i] * w1[1]; gacc[6] += h[i] * w1[2]; gacc[7] += h[i] * w1[3]; } }
#pragma unroll
        for (int q = 0; q < 8; ++q) gacc[q] = wave_sum(gacc[q]);
        if (lane == 0) { *(f32x4*)(gates + (size_t)m * 8) = (f32x4){gacc[0], gacc[1], gacc[2], gacc[3]}; *(f32x4*)(gates + (size_t)m * 8 + 4) = (f32x4){gacc[4], gacc[5], gacc[6], gacc[7]}; }
    }
    __syncthreads();
}

constexpr int L_QS = 0, L_KS = 16896, L_VT = 33792, L_VTW = 40192, L_SS = 46592, L_CS = 49152;
constexpr int L_GFM = 91392, L_GAA = L_GFM + 8192, L_GEN = L_GAA + 8192, L_GWL = L_GEN + 8192, L_GM0 = L_GWL + 8192, L_GDL = L_GM0 + 256, L_GX = L_GDL + 256, L_NQ = L_GX + 256;
static_assert(L_NQ + 512 <= 131072, "LDS map");
#define LDS_BARRIER() do { asm volatile("s_waitcnt lgkmcnt(0)" ::: "memory"); __builtin_amdgcn_s_barrier(); asm volatile("" ::: "memory"); } while (0)
__device__ __forceinline__ float dpp_shr_f(float oldv, float src, int d) {
    int r;
    switch (d) {
        case 1: r = __builtin_amdgcn_update_dpp(__float_as_int(oldv), __float_as_int(src), 0x111, 0xf, 0xf, false); break;
        case 2: r = __builtin_amdgcn_update_dpp(__float_as_int(oldv), __float_as_int(src), 0x112, 0xf, 0xf, false); break;
        case 4: r = __builtin_amdgcn_update_dpp(__float_as_int(oldv), __float_as_int(src), 0x114, 0xf, 0xf, false); break;
        default: r = __builtin_amdgcn_update_dpp(__float_as_int(oldv), __float_as_int(src), 0x118, 0xf, 0xf, false); break;
    }
    return __int_as_float(r);
}
__device__ __forceinline__ void mlstm_item(const Args& a, LAS unsigned char* L, bool sample, int b, int hh, int sl, bool dry = false) {
    OPAQUE_TID();
    bf16_t* U = (bf16_t*)(a.ws + WS_U);
    const float* gates = (const float*)(a.ws + WS_GATES);
    const int g = lane >> 4, lr = lane & 15, t32 = lane & 31;
    const int rowbase = sample ? MP + b * SSEQ : b * SEQ;
    const int nchunks = sample ? 1 : SEQ / 32;
    const float bi = a.in[12][hh], bfv = a.in[13][hh];
    LAS float* GFM = (LAS float*)(L + L_GFM); LAS float* GAA = (LAS float*)(L + L_GAA); LAS float* GEN = (LAS float*)(L + L_GEN); LAS float* GWL = (LAS float*)(L + L_GWL);
    LAS float* GM0 = (LAS float*)(L + L_GM0); LAS float* GDL = (LAS float*)(L + L_GDL); LAS float* GX = (LAS float*)(L + L_GX);
    { const int row = 64 + (tid >> 5), s = tid & 31;
      *(LAS bf16_t*)(L + L_VT + row * 80 + s * 2) = (row == 64) ? (bf16_t)0x3F80 : (bf16_t)0;
      *(LAS bf16_t*)(L + L_VTW + row * 80 + s * 2) = (bf16_t)0; }
    f32x4 Cacc[2][5];
#pragma unroll
    for (int kti = 0; kti < 2; ++kti)
#pragma unroll
        for (int vt = 0; vt < 5; ++vt) Cacc[kti][vt] = (f32x4){0.f, 0.f, 0.f, 0.f};
    float m_init = 0.f;
    if (sample) {
        const float* sC = a.in[5] + (size_t)(b * 4 + hh) * 65536; const float* sn = a.in[6] + (size_t)(b * 4 + hh) * 256;
#pragma unroll
        for (int kti = 0; kti < 2; ++kti)
#pragma unroll
            for (int j = 0; j < 4; ++j) { const int k = (2 * wave + kti) * 16 + g * 4 + j;
#pragma unroll
                for (int vt = 0; vt < 4; ++vt) Cacc[kti][vt][j] = sC[(size_t)k * 256 + sl * 64 + vt * 16 + lr];
                Cacc[kti][4][j] = (lr == 0) ? sn[k] : 0.f; }
        m_init = a.in[7][b * 4 + hh];
    }
#define WRITE_CS() do { _Pragma("unroll") for (int kti = 0; kti < 2; ++kti) _Pragma("unroll") for (int vt = 0; vt < 5; ++vt) \
        *(LAS u32x2*)(L + L_CS + (vt * 16 + lr) * 528 + ((2 * wave + kti) * 16 + g * 4) * 2) = (u32x2){pk2(Cacc[kti][vt][0], Cacc[kti][vt][1]), pk2(Cacc[kti][vt][2], Cacc[kti][vt][3])}; } while (0)
    WRITE_CS();
    u32x4 qreg[2], kreg[2]; u32x2 vreg0 = (u32x2){0u, 0u}, vreg1 = vreg0;
    const int prow = tid >> 5, pcc = tid & 31;
    const int sp = tid & 15, vq = tid >> 4;
#define PREFETCH(c) do { const size_t r0 = (size_t)(rowbase + (c) * 32); \
        _Pragma("unroll") for (int i = 0; i < 2; ++i) { const bf16_t* p = U + (r0 + prow + 16 * i) * LDU + hh * 256 + pcc * 8; qreg[i] = *(const u32x4*)(p + C_Q); kreg[i] = *(const u32x4*)(p + C_K); } \
        if (tid < 256) { const bf16_t* pv = U + (r0 + 2 * sp) * LDU + C_V + hh * 256 + sl * 64 + vq * 4; vreg0 = *(const u32x2*)pv; vreg1 = *(const u32x2*)(pv + LDU); } } while (0)
    PREFETCH(0);
    for (int c = wave; c < nchunks; c += 8) {
        const size_t r0 = (size_t)(rowbase + c * 32 + t32);
        const float ig = gates[r0 * 8 + hh] + bi, xg = gates[r0 * 8 + 4 + hh] + bfv;
        const float lf = fminf(xg, 0.f) - log1pf(__expf(-fabsf(xg)));
        float F = lf;
        F += dpp_shr_f(0.f, F, 1); F += dpp_shr_f(0.f, F, 2); F += dpp_shr_f(0.f, F, 4); F += dpp_shr_f(0.f, F, 8);
        { const float r15 = __int_as_float(__builtin_amdgcn_readlane(__float_as_int(F), 15)); if (lane & 16) F += r15; }
        const float aa = ig - F;
        const float NINF = -__builtin_inff();
        float cm = aa;
        cm = fmaxf(cm, dpp_shr_f(NINF, cm, 1)); cm = fmaxf(cm, dpp_shr_f(NINF, cm, 2)); cm = fmaxf(cm, dpp_shr_f(NINF, cm, 4)); cm = fmaxf(cm, dpp_shr_f(NINF, cm, 8));
        { const float r15 = __int_as_float(__builtin_amdgcn_readlane(__float_as_int(cm), 15)); if (lane & 16) cm = fmaxf(cm, r15); }
        if (lane < 32) { GAA[c * 32 + lane] = aa; GFM[c * 32 + lane] = cm; GEN[c * 32 + lane] = F; }
        if (lane == 31) { GDL[c] = F; GM0[c] = cm; }
    }
    LDS_BARRIER();
    float m_fin;
    {
        const bool act = lane < nchunks;
        const float FLc = act ? GDL[lane] : 0.f, aLc = act ? GM0[lane] : -__builtin_inff();
        float mrun = m_init, my_m0 = m_init; m_fin = m_init;
#pragma unroll
        for (int c = 0; c < 64; ++c) {
            const float fl = __int_as_float(__builtin_amdgcn_readlane(__float_as_int(FLc), c)), al = __int_as_float(__builtin_amdgcn_readlane(__float_as_int(aLc), c));
            if (lane == c) my_m0 = mrun;
            mrun = fl + fmaxf(mrun, al);
            if (c + 1 == nchunks) m_fin = mrun;
        }
        LDS_BARRIER();
        if (wave == 0 && act) { const float mLc = FLc + fmaxf(my_m0, aLc); GM0[lane] = my_m0; GDL[lane] = __expf(my_m0 + FLc - mLc); GX[lane] = FLc - mLc; }
    }
    LDS_BARRIER();
    for (int idx = tid; idx < nchunks * 32; idx += 512) { const int c = idx >> 5; const float m0c = GM0[c], cm = GFM[idx], F = GEN[idx], aa = GAA[idx], mm = fmaxf(m0c, cm);
        GFM[idx] = -mm; GEN[idx] = __expf(-(F + mm)); GWL[idx] = __expf(aa + GX[c]); }
    LDS_BARRIER();
    if (wave >= 4) __builtin_amdgcn_s_setprio(1);
    for (int c = 0; c < nchunks; ++c) {
#pragma unroll
        for (int i = 0; i < 2; ++i) { *(LAS u32x4*)(L + L_QS + (prow + 16 * i) * 528 + pcc * 16) = qreg[i]; *(LAS u32x4*)(L + L_KS + (prow + 16 * i) * 528 + pcc * 16) = kreg[i]; }
        if (tid < 256) {
            const float wL0 = GWL[c * 32 + 2 * sp], wL1 = GWL[c * 32 + 2 * sp + 1];
            const unsigned r0w[2] = {vreg0.x, vreg0.y}, r1w[2] = {vreg1.x, vreg1.y};
#pragma unroll
            for (int i = 0; i < 4; ++i) { const unsigned e0 = (i & 1) ? (r0w[i >> 1] >> 16) : (r0w[i >> 1] & 0xffffu), e1 = (i & 1) ? (r1w[i >> 1] >> 16) : (r1w[i >> 1] & 0xffffu);
                *(LAS unsigned*)(L + L_VT + (vq * 4 + i) * 80 + sp * 4) = e0 | (e1 << 16);
                *(LAS unsigned*)(L + L_VTW + (vq * 4 + i) * 80 + sp * 4) = pk2(bf2f(e0) * wL0, bf2f(e1) * wL1); }
            if (tid < 16) *(LAS unsigned*)(L + L_VTW + 64 * 80 + sp * 4) = pk2(wL0, wL1);
        }
        if (c + 1 < nchunks) PREFETCH(c + 1);
        LDS_BARRIER();
        const float dL = GDL[c], m0c = GM0[c];
        if (wave < 4) {
            const int st = wave >> 1, tt = wave & 1, t = tt * 16 + lr;
            f32x4 s = (f32x4){0.f, 0.f, 0.f, 0.f};
            if (!(st == 1 && tt == 0)) {
                bf16x8 Af[8], Bf[8];
#pragma unroll
                for (int kk = 0; kk < 8; ++kk) { Af[kk] = *(const LAS bf16x8*)(L + L_KS + (st * 16 + lr) * 528 + kk * 64 + g * 16); Bf[kk] = *(const LAS bf16x8*)(L + L_QS + t * 528 + kk * 64 + g * 16); }
                __builtin_amdgcn_sched_barrier(0);
#pragma unroll
                for (int kk = 0; kk < 8; ++kk) s = MFMA16(Af[kk], Bf[kk], s);
            }
            const float fmt = GFM[c * 32 + t];
            const f32x4 as4 = *(const LAS f32x4*)(L + L_GAA + (c * 32 + st * 16 + g * 4) * 4);
            float val[4];
#pragma unroll
            for (int j = 0; j < 4; ++j) { const int si = st * 16 + g * 4 + j; const float e = __expf(fminf(fmt + as4[j], 0.f)); val[j] = (si <= t) ? s[j] * e : 0.f; }
            *(LAS u32x2*)(L + L_SS + t * 80 + (st * 16 + g * 4) * 2) = (u32x2){pk2(val[0], val[1]), pk2(val[2], val[3])};
            float rsum = (val[0] + val[1]) + (val[2] + val[3]);
            rsum += __shfl_xor(rsum, 16); rsum += __shfl_xor(rsum, 32);
            if (g == 0) *(LAS float*)(L + L_NQ + (st * 32 + t) * 4) = rsum;
        } else {
            const int w4 = wave - 4, tt = w4 & 1, kh = w4 >> 1, t = tt * 16 + lr;
            f32x4 cA = (f32x4){0.f, 0.f, 0.f, 0.f};
            bf16x8 Af[4], Bf[4];
#pragma unroll
            for (int kk = 0; kk < 4; ++kk) { const int ko = (kh * 4 + kk) * 64 + g * 16; Af[kk] = *(const LAS bf16x8*)(L + L_CS + (64 + lr) * 528 + ko); Bf[kk] = *(const LAS bf16x8*)(L + L_QS + t * 528 + ko); }
            __builtin_amdgcn_sched_barrier(0);
#pragma unroll
            for (int kk = 0; kk < 4; ++kk) cA = MFMA16(Af[kk], Bf[kk], cA);
            if (g == 0) *(LAS float*)(L + L_NQ + (64 + kh * 32 + t) * 4) = cA[0];
        }
        {
            typedef short v4i16_t __attribute__((ext_vector_type(4)));
            v4i16_t tl[2], th[2]; bf16x8 Bv[5];
#pragma unroll
            for (int kti = 0; kti < 2; ++kti) { const int kt = 2 * wave + kti;
                tl[kti] = __builtin_amdgcn_ds_read_tr16_b64_v4i16((LAS v4i16_t*)(L + L_KS + (g * 8 + (lr >> 2)) * 528 + (kt * 16 + 4 * (lr & 3)) * 2));
                th[kti] = __builtin_amdgcn_ds_read_tr16_b64_v4i16((LAS v4i16_t*)(L + L_KS + (g * 8 + 4 + (lr >> 2)) * 528 + (kt * 16 + 4 * (lr & 3)) * 2)); }
#pragma unroll
            for (int vt = 0; vt < 5; ++vt) Bv[vt] = *(const LAS bf16x8*)(L + L_VTW + (vt * 16 + lr) * 80 + g * 16);
#pragma unroll
            for (int kti = 0; kti < 2; ++kti) { const bf16x8 A = (bf16x8){tl[kti][0], tl[kti][1], tl[kti][2], tl[kti][3], th[kti][0], th[kti][1], th[kti][2], th[kti][3]};
#pragma unroll
                for (int vt = 0; vt < 5; ++vt) Cacc[kti][vt] = MFMA16(A, Bv[vt], Cacc[kti][vt] * dL); }
        }
        LDS_BARRIER();
        {
            const int tt = wave & 1, vt = wave >> 1, t = tt * 16 + lr;
            const bf16x8 Bs = *(const LAS bf16x8*)(L + L_SS + t * 80 + g * 16);
            const f32x4 z4 = (f32x4){0.f, 0.f, 0.f, 0.f};
            const bf16x8 Av = *(const LAS bf16x8*)(L + L_VT + (vt * 16 + lr) * 80 + g * 16);
            bf16x8 Af[8], Bf[8];
#pragma unroll
            for (int kk = 0; kk < 8; ++kk) { Af[kk] = *(const LAS bf16x8*)(L + L_CS + (vt * 16 + lr) * 528 + kk * 64 + g * 16); Bf[kk] = *(const LAS bf16x8*)(L + L_QS + t * 528 + kk * 64 + g * 16); }
            __builtin_amdgcn_sched_barrier(0);
            f32x4 sM = MFMA16(Av, Bs, z4);
            f32x4 cM = z4;
#pragma unroll
            for (int kk = 0; kk < 8; ++kk) cM = MFMA16(Af[kk], Bf[kk], cM);
            const float d0 = __expf(m0c + GFM[c * 32 + t]), en = GEN[c * 32 + t];
            const LAS float* NQ = (const LAS float*)(L + L_NQ);
            const float nq = (NQ[t] + NQ[32 + t]) + d0 * (NQ[64 + t] + NQ[96 + t]);
            const float inv = __builtin_amdgcn_rcpf(fmaxf(fabsf(nq), en));
            float hv[4];
#pragma unroll
            for (int j = 0; j < 4; ++j) hv[j] = (sM[j] + d0 * cM[j]) * inv;
            if (dry) *(u32x2*)((bf16_t*)a.out + (size_t)(rowbase + c * 32 + t) * 1024 + hh * 256 + sl * 64 + vt * 16 + g * 4) = (u32x2){pk2(hv[0], hv[1]), pk2(hv[2], hv[3])};
            else *(u32x2*)(U + (size_t)(rowbase + c * 32 + t) * LDU + C_V + hh * 256 + sl * 64 + vt * 16 + g * 4) = (u32x2){pk2(hv[0], hv[1]), pk2(hv[2], hv[3])};
        }
        LDS_BARRIER();
        WRITE_CS();
    }
    __builtin_amdgcn_s_setprio(0);
    {
        float* oC = a.out + (sample ? O_CS : O_CP) + (size_t)(b * 4 + hh) * 65536;
#pragma unroll
        for (int kti = 0; kti < 2; ++kti)
#pragma unroll
            for (int j = 0; j < 4; ++j) { const int k = (2 * wave + kti) * 16 + g * 4 + j;
#pragma unroll
                for (int vt = 0; vt < 4; ++vt) oC[(size_t)k * 256 + sl * 64 + vt * 16 + lr] = Cacc[kti][vt][j];
                if (sl == 0 && lr == 0) a.out[(sample ? O_NS : O_NP) + (size_t)(b * 4 + hh) * 256 + k] = Cacc[kti][4][j]; }
        if (sl == 0 && tid == 0) a.out[(sample ? O_MS : O_MP) + b * 4 + hh] = m_fin;
    }
    LDS_BARRIER();
#undef WRITE_CS
#undef PREFETCH
}

template <int W>
__device__ __forceinline__ void pool_run(const Args& a, const bf16_t* U, bf16_t* PB, int row0, int ch) {
    const bool sample = row0 >= MP;
    const int b = sample ? (row0 - MP) >> 5 : row0 >> 11, t0 = sample ? (row0 - MP) & 31 : row0 & 2047, T = sample ? SSEQ : SEQ, seqbase = row0 - t0;
    constexpr int NR = W + 15;
    u32x4 rows[NR];
#pragma unroll
    for (int r = 0; r < NR; ++r) {
        const int t = t0 - (W - 1) + r;
        if (t >= 0) rows[r] = *(const u32x4*)(U + (size_t)(seqbase + t) * LDU + C_XP + ch);
        else if (sample) { const float* p = a.in[4] + (size_t)(b * 15 + 15 + t) * 1024 + ch; const f32x4 p0 = *(const f32x4*)p, p1 = *(const f32x4*)(p + 4);
            rows[r] = (u32x4){pk2(p0[0], p0[1]), pk2(p0[2], p0[3]), pk2(p1[0], p1[1]), pk2(p1[2], p1[3])}; }
        else rows[r] = (u32x4){0u, 0u, 0u, 0u};
    }
    float sum[8], cur[8], old[8];
#pragma unroll
    for (int i = 0; i < 8; ++i) sum[i] = 0.f;
#pragma unroll
    for (int r = 0; r < W - 1; ++r) { unpack8(rows[r], old);
#pragma unroll
        for (int i = 0; i < 8; ++i) sum[i] += old[i]; }
#pragma unroll
    for (int i16 = 0; i16 < 16; ++i16) {
        const int t = t0 + i16;
        unpack8(rows[W - 1 + i16], cur); unpack8(rows[i16], old);
        const int cnt = sample ? W : ((t + 1 < W) ? t + 1 : W);
        const float ic = __builtin_amdgcn_rcpf((float)cnt);
        float p[8];
#pragma unroll
        for (int i = 0; i < 8; ++i) { sum[i] += cur[i]; p[i] = sum[i] * ic - cur[i]; sum[i] -= old[i]; }
        *(u32x4*)(PB + (size_t)(row0 + i16) * 1024 + ch) = (u32x4){pk2(p[0], p[1]), pk2(p[2], p[3]), pk2(p[4], p[5]), pk2(p[6], p[7])};
        if (t >= T - 15) { float* op = a.out + (sample ? O_PS : O_PP) + (size_t)(b * 15 + t - (T - 15)) * 1024 + ch;
            *(f32x4*)op = (f32x4){cur[0], cur[1], cur[2], cur[3]}; *(f32x4*)(op + 4) = (f32x4){cur[4], cur[5], cur[6], cur[7]}; }
    }
}
__device__ __forceinline__ void pool_prepass(const Args& a) {
    OPAQUE_TID();
    const bf16_t* U = (const bf16_t*)(a.ws + WS_U);
    bf16_t* PB = (bf16_t*)a.out;
    const int G = gridDim.x, gq = wave & 3, ch = gq * 256 + (lane & 31) * 8;
    for (int it = blockIdx.x; it < MT / 64; it += G) {
        const int row0 = (it * 4 + (wave >> 2) * 2 + (lane >> 5)) * 16;
        if (gq == 0) pool_run<2>(a, U, PB, row0, ch);
        else if (gq == 1) pool_run<4>(a, U, PB, row0, ch);
        else if (gq == 2) pool_run<8>(a, U, PB, row0, ch);
        else pool_run<16>(a, U, PB, row0, ch);
    }
}

__device__ __forceinline__ float half_sum(float v) {
#pragma unroll
    for (int o = 1; o < 32; o <<= 1) v += __shfl_xor(v, o);
    return v;
}
__device__ __forceinline__ void ym_finalize(const Args& a, bool dry = false) {
    OPAQUE_TID();
    bf16_t* U = (bf16_t*)(a.ws + WS_U);
    const int gw = blockIdx.x * 8 + wave, NGW = gridDim.x * 8;
    const int cbase = (lane >> 5) * 256 + 8 * (lane & 31);
    f32x4 gh[2][2];
#pragma unroll
    for (int hp = 0; hp < 2; ++hp) { gh[hp][0] = *(const f32x4*)(a.in[16] + cbase + 512 * hp); gh[hp][1] = *(const f32x4*)(a.in[16] + cbase + 512 * hp + 4); }
    u32x4 nh[2], nz[2];
#define YM_LOAD(row) do { const bf16_t* ur_ = U + (size_t)(row) * LDU + cbase; _Pragma("unroll") for (int hp = 0; hp < 2; ++hp) { \
        nh[hp] = *(const u32x4*)(ur_ + C_V + 512 * hp); nz[hp] = *(const u32x4*)(ur_ + C_ZM + 512 * hp); } } while (0)
    if (gw < MT) YM_LOAD(gw);
    for (int row = gw; row < MT; row += NGW) {
        u32x4 ch[2], cz[2];
#pragma unroll
        for (int hp = 0; hp < 2; ++hp) { ch[hp] = nh[hp]; cz[hp] = nz[hp]; }
        if (row + NGW < MT) YM_LOAD(row + NGW);
#pragma unroll
        for (int hp = 0; hp < 2; ++hp) {
            float x[8], z[8];
            unpack8(ch[hp], x); unpack8(cz[hp], z);
            float sm = 0.f;
#pragma unroll
            for (int i = 0; i < 8; ++i) sm += x[i];
            const float mu = half_sum(sm) * (1.f / 256.f);
            float q = 0.f;
#pragma unroll
            for (int i = 0; i < 8; ++i) { x[i] -= mu; q += x[i] * x[i]; }
            const float rs = rsqrtf(half_sum(q) * (1.f / 256.f) + EPS);
            float y[8];
#pragma unroll
            for (int i = 0; i < 8; ++i) y[i] = x[i] * rs * gh[hp][i >> 2][i & 3] * z[i];
            bf16_t* dst_ = dry ? (bf16_t*)a.out + (size_t)MT * 1024 + (size_t)row * 1024 + cbase + 512 * hp : U + (size_t)row * LDU + cbase + C_ZM + 512 * hp;
            *(u32x4*)dst_ = (u32x4){pk2(y[0], y[1]), pk2(y[2], y[3]), pk2(y[4], y[5]), pk2(y[6], y[7])};
        }
    }
#undef YM_LOAD
}

__device__ __forceinline__ void sample_finalize(const Args& a) {
    OPAQUE_TID();
    const int gw = blockIdx.x * 8 + wave, NGW = gridDim.x * 8;
    const float* part = (const float*)(a.ws + WS_PART); const float* gatef = (const float*)(a.ws + WS_GATEF);
    for (int r = gw; r < MS; r += NGW) {
        f32x4 v[4]; float ss = 0.f;
#pragma unroll
        for (int j = 0; j < 4; ++j) { const int col = 4 * lane + 256 * j;
            f32x4 p = *(const f32x4*)(part + (size_t)r * DM + col);
#pragma unroll
            for (int ks = 1; ks < 4; ++ks) p += *(const f32x4*)(part + ((size_t)ks * MS + r) * DM + col);
            v[j] = *(const f32x4*)(a.in[1] + (size_t)r * DM + col) + *(const f32x4*)(gatef + (16 + (r >> 5)) * DM + col) * p;
            ss += (v[j][0] * v[j][0] + v[j][1] * v[j][1]) + (v[j][2] * v[j][2] + v[j][3] * v[j][3]); }
        const float rr = rsqrtf(wave_sum(ss) * (1.f / DM) + EPS);
#pragma unroll
        for (int j = 0; j < 4; ++j) { const int col = 4 * lane + 256 * j; *(f32x4*)(a.out + (size_t)(MP + r) * DM + col) = v[j] * rr * *(const f32x4*)(a.in[18] + col); }
    }
}

#define XB_TMO      128
#define XB_XCNT(j)  (256  + 64 * (j))
#define XB_XSUB(j)  (1280 + 64 * (j))
#define XB_XGEN(j)  (2304 + 64 * (j))
#define XB_TOP      3328
#define XB_TOPGEN   3392
#define XCD_BAR_WORDS 3456
#define XB_SPIN_CAP (1u << 18)
__device__ __forceinline__ unsigned xb_ld(unsigned* p)              { return __hip_atomic_load(p, __ATOMIC_RELAXED, __HIP_MEMORY_SCOPE_AGENT); }
__device__ __forceinline__ unsigned xb_add(unsigned* p, unsigned v) { return __hip_atomic_fetch_add(p, v, __ATOMIC_RELAXED, __HIP_MEMORY_SCOPE_AGENT); }
__device__ __forceinline__ unsigned xb_xcc_id() { return (unsigned)__builtin_amdgcn_s_getreg((3 << 11) | 20) & 0xFu; }
#define XB_SPIN(cond, bar) do { unsigned _sp = 0; while (cond) { __builtin_amdgcn_s_sleep(1); \
    if ((++_sp & 255u) == 0u) { if (xb_ld(&(bar)[XB_TMO])) break; if (_sp > XB_SPIN_CAP) { atomicAdd(&(bar)[XB_TMO], 1u); break; } } } } while (0)
struct XcdBarrier { unsigned* bar; unsigned x; volatile LAS unsigned* st; };
__device__ __forceinline__ XcdBarrier xcd_barrier_post(unsigned* bar, volatile LAS unsigned* st) {
    XcdBarrier b; b.bar = bar; b.x = xb_xcc_id(); b.st = st;
    if (threadIdx.x == 0) (void)xb_add(&bar[XB_XCNT(b.x)], 1u);
    return b;
}
__device__ __forceinline__ void xcd_barrier_complete(unsigned* bar, unsigned x, unsigned& nloc, unsigned& nx) {
    const unsigned G = gridDim.x * gridDim.y * gridDim.z;
    unsigned sum, cnt, mine, sp = 0u;
    for (;;) {
        sum = 0u; cnt = 0u; mine = 0u;
#pragma unroll
        for (unsigned j = 0; j < 16; ++j) { const unsigned c = xb_ld(&bar[XB_XCNT(j)]); sum += c; cnt += (c > 0u) ? 1u : 0u; mine = (j == x) ? c : mine; }
        if (sum == G) break;
        __builtin_amdgcn_s_sleep(1);
        if ((++sp & 255u) == 0u) { if (xb_ld(&bar[XB_TMO])) break; if (sp > XB_SPIN_CAP) { atomicAdd(&bar[XB_TMO], 1u); break; } }
    }
    nloc = mine > 0u ? mine : 1u; nx = cnt > 0u ? cnt : 1u;
}
__device__ __forceinline__ void xcd_barrier(const XcdBarrier& b) {
    asm volatile("s_waitcnt vmcnt(0)" ::: "memory");
    __syncthreads();
    if (threadIdx.x == 0) {
        unsigned* bar = b.bar;
        __builtin_amdgcn_s_waitcnt(0);
        unsigned nloc = b.st[0], nx = b.st[1];
        if (nloc == 0u) { xcd_barrier_complete(bar, b.x, nloc, nx); b.st[0] = nloc; b.st[1] = nx; }
        const unsigned old = xb_add(&bar[XB_XSUB(b.x)], 1u);
        const unsigned gen = old / nloc;
        if (old + 1u == (gen + 1u) * nloc) {
            __builtin_amdgcn_fence(__ATOMIC_RELEASE, "agent");
            asm volatile("s_waitcnt vmcnt(0)" ::: "memory");
            const unsigned og = xb_add(&bar[XB_TOP], 1u);
            const unsigned tg = og / nx;
            if (og + 1u == (tg + 1u) * nx) xb_add(&bar[XB_TOPGEN], 1u);
            else XB_SPIN(xb_ld(&bar[XB_TOPGEN]) == tg, bar);
            __builtin_amdgcn_fence(__ATOMIC_ACQUIRE, "agent");
            xb_add(&bar[XB_XGEN(b.x)], 1u);
            asm volatile("s_waitcnt vmcnt(0)" ::: "memory");
        } else {
            XB_SPIN(xb_ld(&bar[XB_XGEN(b.x)]) == gen, bar);
            __builtin_amdgcn_fence(__ATOMIC_ACQUIRE, "agent");
            asm volatile("s_waitcnt vmcnt(0)" ::: "memory");
        }
    }
    __syncthreads();
}

__global__ void __launch_bounds__(512, 2) fwd_megakernel(Args a) {
    extern __shared__ __attribute__((aligned(16))) unsigned char lds_raw[];
    LAS unsigned char* L = (LAS unsigned char*)lds_raw;
    cg::grid_group grid = cg::this_grid();
    const int bid = blockIdx.x, G = gridDim.x;
    bf16_t* U = (bf16_t*)(a.ws + WS_U);
    if (threadIdx.x < 4) ((LAS unsigned*)(L + L_MISC))[threadIdx.x] = 0u;
    __syncthreads();
    const XcdBarrier xbar = xcd_barrier_post((unsigned*)(a.ws + WS_CTL), (volatile LAS unsigned*)(L + L_MISC));

    phase0(a, L);
    if (a.out == nullptr) grid.sync();
    xcd_barrier(xbar);
    phase1(a, L);
    xcd_barrier(xbar);
    {
        pg8::Gemm g{(const bf16_t*)a.out, (const bf16_t*)(a.ws + WS_WIN), MT, LDU, 1024, 1024, 1024, 0};
        pg8::StaticOrder S; S.init(MT, LDU, G, bid);
        pg8::EpiBf16 E{U, LDU, 8, 16, 4, 8};
        pg8::gemm_phase<pg8::EpiBf16, pg8::StaticOrder, true, true>(L, g, S, E);
    }
    xcd_barrier(xbar);
    {
        for (int it = bid; it < 256; it += G) { const int x = it & 7, loc = it >> 3, bh = x * 8 + (loc >> 2); mlstm_item(a, L, false, bh >> 2, bh & 3, loc & 3); }
        for (int it = bid; it < 512; it += G) { const int x = it & 7, loc = it >> 3, bh = x * 16 + (loc >> 2); mlstm_item(a, L, true, bh >> 2, bh & 3, loc & 3); }
        pool_prepass(a);
    }
    xcd_barrier(xbar);
    {
        ym_finalize(a);
        pg8::Gemm g{(const bf16_t*)a.out, (const bf16_t*)(a.ws + WS_WPOOL), MT, 1024, 256, 1024, 256, 256};
        pg8::StaticOrder S; S.init(MT, 1024, G, bid, 256);
        pg8::EpiPool E{U, a.in[15], nullptr};
        pg8::gemm_phase<pg8::EpiPool, pg8::StaticOrder, true, true>(L, g, S, E);
    }
    xcd_barrier(xbar);
    {
        pg8::Gemm g{U + C_ZP, (const bf16_t*)(a.ws + WS_WOUT), MP, 1024, 2048, LDU, 2048, 0};
        pg8::PanelOrder S{bid};
        pg8::EpiResLN E{a.in[0], (const float*)(a.ws + WS_GATEF), a.in[18], a.out, (float*)(a.ws + WS_XBUF), (unsigned*)(a.ws + WS_CTL) + 4096};
        pg8::gemm_phase<pg8::EpiResLN, pg8::PanelOrder, true, true>(L, g, S, E);
        pg8::Gemm g2{U + C_ZP, (const bf16_t*)(a.ws + WS_WOUT), MT, 1024, 512, LDU, 2048, 0};
        pg8::SampleOrder S2{bid};
        pg8::EpiPart E2{(float*)(a.ws + WS_PART)};
        pg8::gemm_phase<pg8::EpiPart, pg8::SampleOrder, true, true>(L, g2, S2, E2);
    }
    xcd_barrier(xbar);
    sample_finalize(a);
}

extern "C" void kernel_launch(void* const* d_in, const int* in_sizes, int n_in, void* d_out, int out_size, void* d_ws, size_t ws_size, hipStream_t stream) {
    static int grid = 0;
    if (grid == 0) {
        if (n_in != 19 || ws_size < WS_END) { fprintf(stderr, "kernel_launch: unexpected inputs (n_in %d, ws %zu)\n", n_in, ws_size); grid = -1; return; }
        int dev = 0, cus = 0, per_cu = 0;
        hipGetDevice(&dev);
        hipDeviceGetAttribute(&cus, hipDeviceAttributeMultiprocessorCount, dev);
        hipFuncSetAttribute((const void*)fwd_megakernel, hipFuncAttributeMaxDynamicSharedMemorySize, LDS_BYTES);
        hipOccupancyMaxActiveBlocksPerMultiprocessor(&per_cu, (const void*)fwd_megakernel, 512, LDS_BYTES);
        if (per_cu < 1) per_cu = 1;
        (void)hipGetLastError();
        grid = cus * per_cu;
        if (grid != 256) { fprintf(stderr, "kernel_launch: this kernel needs exactly 256 co-resident workgroups (got %d)\n", grid); grid = -1; return; }
    }
    if (grid < 0) return;
    (void)hipMemsetAsync((char*)d_ws + WS_CTL, 0, 32768, stream);
    Args a{};
    for (int i = 0; i < 19; ++i) a.in[i] = (const float*)d_in[i];
    a.out = (float*)d_out; a.ws = (unsigned char*)d_ws;
    void* args[] = {&a};
    hipError_t e = hipLaunchCooperativeKernel((const void*)fwd_megakernel, dim3(grid), dim3(512), args, LDS_BYTES, stream);
    if (e != hipSuccess) fprintf(stderr, "cooperative launch failed: %s (grid %d)\n", hipGetErrorString(e), grid);
}
```

```cpp
#include <hip/hip_runtime.h>
#include <hip/hip_cooperative_groups.h>
#include <cstdio>
#include <cstdint>
#ifndef PROBE_DUP
#define PROBE_DUP 0
#endif
namespace cg = cooperative_groups;

#define LAS __attribute__((address_space(3)))
typedef unsigned short bf16_t;
typedef short bf16x8 __attribute__((ext_vector_type(8)));
typedef float f32x4 __attribute__((ext_vector_type(4)));
typedef unsigned u32x4 __attribute__((ext_vector_type(4)));
typedef unsigned u32x2 __attribute__((ext_vector_type(2)));

constexpr int DM = 1024, NPB = 16, SEQ = 2048, NSB = 32, SSEQ = 32;
constexpr int MP = NPB * SEQ, MS = NSB * SSEQ, MT = MP + MS;
constexpr int LDU = 7168;
constexpr int C_XP = 0, C_ZP = 1024, C_ZM = 2048  , C_Q = 4096, C_K = 5120, C_V = 6144;
constexpr int WIN_LD = 7176;
constexpr float EPS = 1e-6f;
constexpr size_t O_Y = 0, O_PP = 34603008, O_CP = 34848768, O_NP = 39043072, O_MP = 39059456, O_PS = 39059520, O_CS = 39551040, O_NS = 47939648, O_MS = 47972416;
constexpr size_t MiB = 1u << 20;
constexpr size_t WS_U = 0, WS_WIN = 462 * MiB, WS_WOUT = 476 * MiB, WS_WPOOL = 480 * MiB, WS_MODP = 481 * MiB, WS_GATEF = 484 * MiB, WS_GATES = 485 * MiB, WS_CTL = 487 * MiB, WS_XBUF = 488 * MiB, WS_PART = 489 * MiB, WS_END = 505 * MiB;
constexpr int LDS_BYTES = 143360, L_MISC = 131072 + 2048, L_XP = 131072 + 4096, L_XS = L_XP + 4096;

struct Args { const float* in[19]; float* out; unsigned char* ws; };

__device__ __forceinline__ float bf2f(unsigned b) { return __uint_as_float(b << 16); }
__device__ __forceinline__ unsigned f2bf(float f) { unsigned u = __float_as_uint(f); return (u + 0x7fffu + ((u >> 16) & 1u)) >> 16; }
__device__ __forceinline__ unsigned pk2(float lo, float hi) { unsigned r; asm("v_cvt_pk_bf16_f32 %0, %1, %2" : "=v"(r) : "v"(lo), "v"(hi)); return r; }
__device__ __forceinline__ float wave_sum(float v) {
#pragma unroll
    for (int o = 1; o < 64; o <<= 1) v += __shfl_xor(v, o);
    return v;
}
__device__ __forceinline__ float sigmoidf_(float x) { return __builtin_amdgcn_rcpf(1.f + __builtin_amdgcn_exp2f(x * -1.44269504f)); }
__device__ __forceinline__ void unpack8(const u32x4 z, float (&o)[8]) {
    o[0] = bf2f(z.x & 0xffffu); o[1] = bf2f(z.x >> 16); o[2] = bf2f(z.y & 0xffffu); o[3] = bf2f(z.y >> 16); o[4] = bf2f(z.z & 0xffffu); o[5] = bf2f(z.z >> 16); o[6] = bf2f(z.w & 0xffffu); o[7] = bf2f(z.w >> 16);
}

namespace pg8 {
constexpr int BM = 256, BK = 64, HALF = 128, HTB = HALF * BK * 2, STAGE_BYTES = 8 * HTB, NXCD = 8, WGM = 8;
__host__ __device__ __forceinline__ int lds_byte(int r, int c) { const int st = (r >> 4) * 2 + (c >> 5), rr = r & 15, cc = c & 31, ob = rr * 64 + cc * 2; return st * 1024 + (ob ^ (((ob >> 9) & 1) << 5)); }
__host__ __device__ __forceinline__ void stage_rc(int b, int& R, int& C) { const int st = b / 1024, sb = b % 1024, swz = sb ^ (((sb >> 9) & 1) << 5); R = (st >> 1) * 16 + swz / 64; C = (st & 1) * 32 + (swz % 64) / 2; }
__host__ __device__ __forceinline__ int perm32(int rho) { const int n = rho >> 4, i = rho & 15; return 8 * (i >> 2) + 4 * n + (i & 3); }

struct Unit { int pm, pn, ao, bo, ks; };
struct Gemm { const bf16_t* A; const bf16_t* Bt; int M, N, K, lda, ldb, acol; };

struct StaticOrder {
    int nM, nN, nwg, G, c, acol;
    __device__ void init(int M, int N, int G_, int c_, int acol_ = 0) { nM = M / BM; nN = N / BM; nwg = nM * nN; G = G_; c = c_; acol = acol_; }
    __device__ bool next(int i, Unit& u) const {
        const long L = (long)i * G + c; if (L >= nwg) return false;
        int wgid = (int)L; { const int q = nwg / NXCD, r = nwg % NXCD, xcd = wgid % NXCD, off = wgid / NXCD; wgid = (xcd < r ? xcd * (q + 1) : r * (q + 1) + (xcd - r) * q) + off; }
        const int nig = WGM * nN, gid = wgid / nig, fm = gid * WGM, gsz = (nM - fm) < WGM ? (nM - fm) : WGM;
        u.pm = fm + ((wgid % nig) % gsz); u.pn = (wgid % nig) / gsz; u.ao = u.pn * acol; u.bo = 0; u.ks = 0; return true;
    }
};


struct PanelOrder {
    int c;
    __device__ bool next(int i, Unit& u) const { if (i >= 2) return false; const int x = c & 7, j = c >> 3; u.pm = 64 * i + 8 * x + (j >> 2); u.pn = j & 3; u.ao = 0; u.bo = 0; u.ks = 0; return true; }
};
struct PoolOrder {
    int c;
    __device__ bool next(int i, Unit& u) const {
        if (i < 2) { const int x = c & 7, j = c >> 3; u.pm = 64 * i + 8 * x + (j >> 2); u.pn = j & 3; }
        else if (i == 2 && (c & 15) == 0) { const int k = c >> 4; u.pm = 128 + (k >> 2); u.pn = k & 3; }
        else return false;
        u.ao = u.pn * 256; u.bo = 0; u.ks = 0; return true; }
};
struct SampleOrder {
    int c;
    __device__ bool next(int i, Unit& u) const { if (i >= 1 || c >= 64) return false; u.pm = 128 + (c & 3); u.pn = (c >> 2) & 3; u.ks = c >> 4; u.ao = u.ks * 512; u.bo = u.ks * 512; return true; }
};

struct EpiBf16 {
    bf16_t* O; int ldc, gm_lo, gm_hi, silu_lo, silu_hi;
    __device__ __forceinline__ void operator()(f32x4 (&acc)[2][2][4][2], const Unit& u, int wr, int wc, int fr, int fq, LAS unsigned char* lds) const {
        int t_ = threadIdx.x; asm volatile("" : "+v"(t_)); fr = t_ & 15; fq = (t_ >> 4) & 3;
        const int row0 = u.pm * BM + wr * 64 + fr; const int col0 = u.pn * BM + wc * 32 + 8 * fq;
#pragma unroll
        for (int ai = 0; ai < 2; ++ai)
#pragma unroll
            for (int m = 0; m < 4; ++m) { bf16_t* rowp = O + (size_t)(row0 + ai * HALF + m * 16) * ldc + col0;
#pragma unroll
                for (int bj = 0; bj < 2; ++bj) { const f32x4 v0 = acc[ai][bj][m][0], v1 = acc[ai][bj][m][1];
                    if (gm_lo <= u.pn && u.pn < gm_hi) {
                        float gmv[4];
#pragma unroll
                        for (int i = 0; i < 4; ++i) gmv[i] = sigmoidf_(v0[i]) * v1[i] * sigmoidf_(v1[i]);
                        *(u32x2*)(O + (size_t)(row0 + ai * HALF + m * 16) * ldc + gm_lo * BM + ((col0 + bj * HALF - gm_lo * BM) >> 1)) = (u32x2){pk2(gmv[0], gmv[1]), pk2(gmv[2], gmv[3])};
                    } else {
                    f32x4 s0 = v0, s1 = v1;
                    if (silu_lo <= u.pn && u.pn < silu_hi) {
#pragma unroll
                        for (int i = 0; i < 4; ++i) { s0[i] = v0[i] * sigmoidf_(v0[i]); s1[i] = v1[i] * sigmoidf_(v1[i]); } }
                    u32x4 w; w.x = pk2(s0[0], s0[1]); w.y = pk2(s0[2], s0[3]); w.z = pk2(s1[0], s1[1]); w.w = pk2(s1[2], s1[3]);
                    *(u32x4*)(rowp + bj * HALF) = w; } } }
    }
};
struct EpiPool {
    bf16_t* U; const float* pscale; bf16_t* dry;
    __device__ __forceinline__ void operator()(f32x4 (&acc)[2][2][4][2], const Unit& u, int wr, int wc, int fr, int fq, LAS unsigned char* lds) const {
        int t_ = threadIdx.x; asm volatile("" : "+v"(t_)); fr = t_ & 15; fq = (t_ >> 4) & 3;
        const int row0 = u.pm * BM + wr * 64 + fr; const int col0 = u.pn * BM + wc * 32 + 8 * fq;
        f32x4 ps[2][2];
#pragma unroll
        for (int bj = 0; bj < 2; ++bj) { ps[bj][0] = *(const f32x4*)(pscale + col0 + bj * HALF); ps[bj][1] = *(const f32x4*)(pscale + col0 + bj * HALF + 4); }
#pragma unroll
        for (int ai = 0; ai < 2; ++ai) {
            u32x4 zz[4][2];
#pragma unroll
            for (int m = 0; m < 4; ++m)
#pragma unroll
                for (int bj = 0; bj < 2; ++bj) zz[m][bj] = *(const u32x4*)(U + (size_t)(row0 + ai * HALF + m * 16) * LDU + C_ZP + col0 + bj * HALF);
#pragma unroll
            for (int m = 0; m < 4; ++m) { bf16_t* rowp = U + (size_t)(row0 + ai * HALF + m * 16) * LDU + C_ZP + col0;
#pragma unroll
                for (int bj = 0; bj < 2; ++bj) {
                    const f32x4 v0 = acc[ai][bj][m][0] * ps[bj][0], v1 = acc[ai][bj][m][1] * ps[bj][1];
                    float zf[8]; unpack8(zz[m][bj], zf);
                    float y[8];
#pragma unroll
                    for (int i = 0; i < 4; ++i) { y[i] = v0[i] * zf[i]; y[4 + i] = v1[i] * zf[4 + i]; }
                    u32x4 w; w.x = pk2(y[0], y[1]); w.y = pk2(y[2], y[3]); w.z = pk2(y[4], y[5]); w.w = pk2(y[6], y[7]);
                    *(u32x4*)(rowp + bj * HALF) = w; } }
        }
    }
};
struct EpiResLN {
    const float* xp; const float* gatef; const float* gfin; float* out; float* xbuf; unsigned* flags;
    __device__ __forceinline__ void operator()(f32x4 (&acc)[2][2][4][2], const Unit& u, int wr, int wc, int fr, int fq, LAS unsigned char* lds) const {
        int t_ = threadIdx.x; asm volatile("" : "+v"(t_)); fr = t_ & 15; fq = (t_ >> 4) & 3;
        const int row0 = u.pm * BM + wr * 64 + fr; const int col0 = u.pn * BM + wc * 32 + 8 * fq;
        LAS float* P = (LAS float*)(lds + L_XP); LAS float* S = (LAS float*)(lds + L_XS);
        {
            const float* gr = gatef + (u.pm >> 3) * DM + col0;
            f32x4 gv[2][2];
#pragma unroll
            for (int bj = 0; bj < 2; ++bj) { gv[bj][0] = *(const f32x4*)(gr + bj * HALF); gv[bj][1] = *(const f32x4*)(gr + bj * HALF + 4); }
#pragma unroll
            for (int ai = 0; ai < 2; ++ai)
#pragma unroll
                for (int m = 0; m < 4; ++m) { int rr_ = row0 + ai * HALF + m * 16; asm volatile("" : "+v"(rr_)); const float* xr = xp + (size_t)rr_ * DM + col0;
                    float sq = 0.f;
#pragma unroll
                    for (int bj = 0; bj < 2; ++bj) { const f32x4 v0 = *(const f32x4*)(xr + bj * HALF) + gv[bj][0] * acc[ai][bj][m][0], v1 = *(const f32x4*)(xr + bj * HALF + 4) + gv[bj][1] * acc[ai][bj][m][1];
                        acc[ai][bj][m][0] = v0; acc[ai][bj][m][1] = v1;
                        sq += ((v0[0] * v0[0] + v0[1] * v0[1]) + (v0[2] * v0[2] + v0[3] * v0[3])) + ((v1[0] * v1[0] + v1[1] * v1[1]) + (v1[2] * v1[2] + v1[3] * v1[3])); }
                    sq += __shfl_xor(sq, 16); sq += __shfl_xor(sq, 32);
                    if (fq == 0) P[(ai * HALF + wr * 64 + m * 16 + fr) * 4 + wc] = sq; }
        }
        __syncthreads();
        if (t_ < 256) { const f32x4 p4 = *(const LAS f32x4*)(P + t_ * 4);
            __hip_atomic_store(xbuf + (size_t)(u.pm * 4 + u.pn) * 256 + t_, (p4[0] + p4[1]) + (p4[2] + p4[3]), __ATOMIC_RELAXED, __HIP_MEMORY_SCOPE_AGENT); }
        asm volatile("s_waitcnt vmcnt(0)" ::: "memory");
        __syncthreads();
        if (t_ == 0) { unsigned* f = flags + u.pm * 16;
            (void)__hip_atomic_fetch_add(f, 1u, __ATOMIC_RELAXED, __HIP_MEMORY_SCOPE_AGENT);
            unsigned sp = 0u;
            while (__hip_atomic_load(f, __ATOMIC_RELAXED, __HIP_MEMORY_SCOPE_AGENT) < 4u) { __builtin_amdgcn_s_sleep(1); if (++sp > (1u << 22)) break; }
            __builtin_amdgcn_fence(__ATOMIC_ACQUIRE, "agent");
            asm volatile("s_waitcnt vmcnt(0)" ::: "memory"); }
        __syncthreads();
        if (t_ < 256) { float tot = 0.f;
#pragma unroll
            for (int q = 0; q < 4; ++q) tot += __hip_atomic_load(xbuf + (size_t)(u.pm * 4 + q) * 256 + t_, __ATOMIC_RELAXED, __HIP_MEMORY_SCOPE_AGENT);
            S[t_] = rsqrtf(tot * (1.f / DM) + EPS); }
        __syncthreads();
        {
            f32x4 gf[2][2];
#pragma unroll
            for (int bj = 0; bj < 2; ++bj) { gf[bj][0] = *(const f32x4*)(gfin + col0 + bj * HALF); gf[bj][1] = *(const f32x4*)(gfin + col0 + bj * HALF + 4); }
#pragma unroll
            for (int ai = 0; ai < 2; ++ai)
#pragma unroll
                for (int m = 0; m < 4; ++m) { const float rs = S[ai * HALF + wr * 64 + m * 16 + fr]; int rr_ = row0 + ai * HALF + m * 16; asm volatile("" : "+v"(rr_)); float* orow = out + (size_t)rr_ * DM + col0;
#pragma unroll
                    for (int bj = 0; bj < 2; ++bj) { *(f32x4*)(orow + bj * HALF) = acc[ai][bj][m][0] * rs * gf[bj][0]; *(f32x4*)(orow + bj * HALF + 4) = acc[ai][bj][m][1] * rs * gf[bj][1]; } }
        }
    }
};
struct EpiPart {
    float* part;
    __device__ __forceinline__ void operator()(f32x4 (&acc)[2][2][4][2], const Unit& u, int wr, int wc, int fr, int fq, LAS unsigned char* lds) const {
        int t_ = threadIdx.x; asm volatile("" : "+v"(t_)); fr = t_ & 15; fq = (t_ >> 4) & 3;
        const int row0 = u.pm * BM + wr * 64 + fr - MP; const int col0 = u.pn * BM + wc * 32 + 8 * fq;
#pragma unroll
        for (int ai = 0; ai < 2; ++ai)
#pragma unroll
            for (int m = 0; m < 4; ++m) { float* orow = part + ((size_t)u.ks * MS + row0 + ai * HALF + m * 16) * DM + col0;
#pragma unroll
                for (int bj = 0; bj < 2; ++bj) { *(f32x4*)(orow + bj * HALF) = acc[ai][bj][m][0]; *(f32x4*)(orow + bj * HALF + 4) = acc[ai][bj][m][1]; } }
    }
};

template <class Epi, class Sched, bool ALIGN_EPI, bool SP2>
__device__ __forceinline__ void gemm_phase(LAS unsigned char* lds, const Gemm g, const Sched& S, const Epi& E) {
    int tid = threadIdx.x; asm volatile("" : "+v"(tid));
    const int wid = __builtin_amdgcn_readfirstlane(tid >> 6), lane = tid & 63, wr = wid >> 2, wc = wid & 3, fr = lane & 15, fq = lane >> 4;
    const int K = g.K, nt = K / BK, lda = g.lda;
    unsigned voffA[2], voffB[2];
#pragma unroll
    for (int i = 0; i < 2; ++i) { int R, C; stage_rc(tid * 16 + i * 8192, R, C); const int Rb = (R & ~31) + perm32(R & 31);
        voffA[i] = (unsigned)(R * lda + C) * 2u; voffB[i] = (unsigned)(Rb * g.ldb + C) * 2u; }
    const size_t kstep = (size_t)(BK * 2);
    const size_t hstepA = (size_t)HALF * lda * 2, hstepB = (size_t)HALF * g.ldb * 2;
    const size_t tstepA = 2 * hstepA, tstepB = 2 * hstepB;
    const unsigned ldsw = (unsigned)wid * 1024u;
    const int aoff = lds_byte(wr * 64 + fr, fq * 8), boff = lds_byte(wc * 32 + fr, fq * 8);
#define PG8_SA(b, h) (((b) * 2 + (h)) * HTB)
#define PG8_SB(b, h) ((4 + (b) * 2 + (h)) * HTB)
#define PG8_STAGE(bufoff, gbase, voff) do { _Pragma("unroll") for (int _i = 0; _i < 2; ++_i) \
        __builtin_amdgcn_global_load_lds((const unsigned*)((const char*)(gbase) + (voff)[_i]), (LAS unsigned*)(lds + (bufoff) + ldsw + _i * 8192), 16, 0, 0); } while (0)
#define PG8_LDA(dst, b, h) do { _Pragma("unroll") for (int m = 0; m < 4; ++m) _Pragma("unroll") for (int k = 0; k < 2; ++k) dst[m][k] = *(const LAS bf16x8*)(lds + PG8_SA(b, h) + aoff + m * 2048 + k * 1024); } while (0)
#define PG8_LDB(dst, b, h) do { _Pragma("unroll") for (int n = 0; n < 2; ++n) _Pragma("unroll") for (int k = 0; k < 2; ++k) dst[n][k] = *(const LAS bf16x8*)(lds + PG8_SB(b, h) + boff + n * 2048 + k * 1024); } while (0)
#define PG8_MMA(ai, bj, At, Bt) do { __builtin_amdgcn_s_setprio(1); _Pragma("unroll") for (int m = 0; m < 4; ++m) _Pragma("unroll") for (int n = 0; n < 2; ++n) _Pragma("unroll") for (int k = 0; k < 2; ++k) \
        acc[ai][bj][m][n] = __builtin_amdgcn_mfma_f32_16x16x32_bf16(Bt[n][k], At[m][k], acc[ai][bj][m][n], 0, 0, 0); __builtin_amdgcn_s_setprio(0); } while (0)
#define PG8_WAIT_V(n) asm volatile("s_waitcnt vmcnt(" #n ")" ::: "memory")
#define PG8_WAIT_L(n) asm volatile("s_waitcnt lgkmcnt(" #n ")" ::: "memory")
#define PG8_BAR __builtin_amdgcn_s_barrier()
#define PG8_SCHED __builtin_amdgcn_sched_barrier(0)
    Unit cur, nxt; int ui = 0;
    if (!S.next(0, cur)) return;
    f32x4 acc[2][2][4][2];
#pragma unroll
    for (int a = 0; a < 2; ++a)
#pragma unroll
        for (int b = 0; b < 2; ++b)
#pragma unroll
            for (int m = 0; m < 4; ++m)
#pragma unroll
                for (int n = 0; n < 2; ++n) acc[a][b][m][n] = (f32x4){0.f, 0.f, 0.f, 0.f};
    bf16x8 At[4][2], B0[2][2], B1[2][2];
    const char* cA = (const char*)g.A + (size_t)cur.pm * tstepA + (size_t)cur.ao * 2; const char* cB = (const char*)g.Bt + (size_t)cur.pn * tstepB + (size_t)cur.bo * 2;
    if constexpr (SP2) {
        PG8_STAGE(PG8_SB(0, 0), cB, voffB); PG8_STAGE(PG8_SB(0, 1), cB + hstepB, voffB); PG8_STAGE(PG8_SA(0, 0), cA, voffA); PG8_STAGE(PG8_SA(0, 1), cA + hstepA, voffA);
        if (wr == 1) PG8_BAR;
        PG8_WAIT_V(2); PG8_BAR;
        PG8_STAGE(PG8_SB(1, 0), cB + kstep, voffB); PG8_STAGE(PG8_SA(1, 0), cA + kstep, voffA); PG8_STAGE(PG8_SB(1, 1), cB + hstepB + kstep, voffB);
        PG8_WAIT_V(6); PG8_BAR;
    } else {
        PG8_STAGE(PG8_SB(0, 0), cB, voffB); PG8_STAGE(PG8_SA(0, 0), cA, voffA); PG8_STAGE(PG8_SB(0, 1), cB + hstepB, voffB); PG8_STAGE(PG8_SA(0, 1), cA + hstepA, voffA);
        if (wr == 1) PG8_BAR;
        PG8_WAIT_V(4); PG8_BAR;
        PG8_STAGE(PG8_SB(1, 0), cB + kstep, voffB); PG8_STAGE(PG8_SA(1, 0), cA + kstep, voffA); PG8_STAGE(PG8_SB(1, 1), cB + hstepB + kstep, voffB);
        PG8_WAIT_V(6); PG8_BAR;
    }
    for (;;) {
        const bool has_next = S.next(ui + 1, nxt);
        const char* nA = has_next ? (const char*)g.A + (size_t)nxt.pm * tstepA + (size_t)nxt.ao * 2 : cA; const char* nB = has_next ? (const char*)g.Bt + (size_t)nxt.pn * tstepB + (size_t)nxt.bo * 2 : cB;
        for (int t = 0; t < nt; t += 2) {
            const bool last = (t == nt - 2);
            const char* a1 = cA + (size_t)(t + 1) * kstep;
            const char* a2 = last ? nA : cA + (size_t)(t + 2) * kstep; const char* b2 = last ? nB : cB + (size_t)(t + 2) * kstep;
            const char* a3 = a2 + kstep; const char* b3 = b2 + kstep;
            if constexpr (SP2) {
            PG8_LDB(B0, 0, 0); PG8_LDB(B1, 0, 1); PG8_SCHED; PG8_LDA(At, 0, 0); PG8_STAGE(PG8_SA(1, 1), a1 + hstepA, voffA);
            PG8_WAIT_V(8); PG8_WAIT_L(0); PG8_BAR; PG8_MMA(0, 0, At, B0); PG8_MMA(0, 1, At, B1); PG8_BAR; PG8_SCHED;
            PG8_LDA(At, 0, 1); PG8_STAGE(PG8_SB(0, 0), b2, voffB); PG8_STAGE(PG8_SB(0, 1), b2 + hstepB, voffB); PG8_STAGE(PG8_SA(0, 0), a2, voffA);
            PG8_WAIT_V(8); PG8_WAIT_L(0); PG8_BAR; PG8_MMA(1, 0, At, B0); PG8_MMA(1, 1, At, B1); PG8_BAR; PG8_SCHED;
            PG8_LDB(B0, 1, 0); PG8_LDB(B1, 1, 1); PG8_SCHED; PG8_LDA(At, 1, 0); PG8_STAGE(PG8_SA(0, 1), a2 + hstepA, voffA);
            PG8_WAIT_V(8); PG8_WAIT_L(0); PG8_BAR; PG8_MMA(0, 0, At, B0); PG8_MMA(0, 1, At, B1); PG8_BAR; PG8_SCHED;
            PG8_LDA(At, 1, 1); PG8_STAGE(PG8_SB(1, 0), b3, voffB); PG8_STAGE(PG8_SB(1, 1), b3 + hstepB, voffB); PG8_STAGE(PG8_SA(1, 0), a3, voffA);
            PG8_WAIT_V(8); PG8_WAIT_L(0); PG8_BAR; PG8_MMA(1, 0, At, B0); PG8_MMA(1, 1, At, B1); PG8_BAR; PG8_SCHED;
            } else {
            PG8_LDB(B0, 0, 0); PG8_SCHED; PG8_LDA(At, 0, 0); PG8_STAGE(PG8_SA(1, 1), a1 + hstepA, voffA);
            PG8_WAIT_L(8); PG8_BAR; PG8_WAIT_L(0); PG8_MMA(0, 0, At, B0); PG8_BAR; PG8_SCHED;
            PG8_LDB(B1, 0, 1); PG8_STAGE(PG8_SB(0, 0), b2, voffB);
            PG8_BAR; PG8_WAIT_L(0); PG8_MMA(0, 1, At, B1); PG8_BAR;
            PG8_LDA(At, 0, 1); PG8_STAGE(PG8_SA(0, 0), a2, voffA);
            PG8_BAR; PG8_WAIT_L(0); PG8_MMA(1, 0, At, B0); PG8_BAR; PG8_SCHED;
            PG8_STAGE(PG8_SB(0, 1), b2 + hstepB, voffB);
            PG8_WAIT_V(6); PG8_BAR; PG8_MMA(1, 1, At, B1); PG8_BAR;
            PG8_LDB(B0, 1, 0); PG8_SCHED; PG8_LDA(At, 1, 0); PG8_STAGE(PG8_SA(0, 1), a2 + hstepA, voffA);
            PG8_WAIT_L(8); PG8_BAR; PG8_WAIT_L(0); PG8_MMA(0, 0, At, B0); PG8_BAR; PG8_SCHED;
            PG8_LDB(B1, 1, 1); PG8_STAGE(PG8_SB(1, 0), b3, voffB);
            PG8_BAR; PG8_WAIT_L(0); PG8_MMA(0, 1, At, B1); PG8_BAR;
            PG8_LDA(At, 1, 1); PG8_STAGE(PG8_SA(1, 0), a3, voffA);
            PG8_BAR; PG8_WAIT_L(0); PG8_MMA(1, 0, At, B0); PG8_BAR; PG8_SCHED;
            PG8_STAGE(PG8_SB(1, 1), b3 + hstepB, voffB);
            PG8_WAIT_V(6); PG8_BAR; PG8_MMA(1, 1, At, B1); PG8_BAR;
            }
        }
        if constexpr (ALIGN_EPI) { if (wr == 0) PG8_BAR; }
        E(acc, cur, wr, wc, fr, fq, lds);
        if (!has_next) break;
#pragma unroll
        for (int a = 0; a < 2; ++a)
#pragma unroll
            for (int b = 0; b < 2; ++b)
#pragma unroll
                for (int m = 0; m < 4; ++m)
#pragma unroll
                    for (int n = 0; n < 2; ++n) acc[a][b][m][n] = (f32x4){0.f, 0.f, 0.f, 0.f};
        cur = nxt; cA = nA; cB = nB; ++ui;
        if constexpr (ALIGN_EPI) { if (wr == 1) PG8_BAR; }
    }
    PG8_WAIT_V(0);
    if constexpr (!ALIGN_EPI) { if (wr == 0) PG8_BAR; }
    PG8_BAR;
#undef PG8_SA
#undef PG8_SB
#undef PG8_STAGE
#undef PG8_LDA
#undef PG8_LDB
#undef PG8_MMA
#undef PG8_WAIT_V
#undef PG8_WAIT_L
#undef PG8_BAR
#undef PG8_SCHED
}
}

#define MFMA16(a, b, c) __builtin_amdgcn_mfma_f32_16x16x32_bf16((a), (b), (c), 0, 0, 0)

__device__ __forceinline__ void transpose_item(const float* W, int ldw, int scol  , bf16_t* WT, int Kd, int drow, int k0, float scale, LAS float* scr, int lane) {
#pragma unroll
    for (int i = 0; i < 32; ++i) { const int kk = 2 * i + (lane >> 5); scr[kk * 33 + (lane & 31)] = W[(size_t)(k0 + kk) * ldw + scol]; }
    asm volatile("s_waitcnt lgkmcnt(0)" ::: "memory");
    const int c = lane & 7;
#pragma unroll
    for (int j = 0; j < 4; ++j) { const int n = (lane >> 3) + 8 * j; const LAS float* s = scr + (8 * c) * 33 + n;
        u32x4 o; o.x = pk2(s[0 * 33] * scale, s[1 * 33] * scale); o.y = pk2(s[2 * 33] * scale, s[3 * 33] * scale); o.z = pk2(s[4 * 33] * scale, s[5 * 33] * scale); o.w = pk2(s[6 * 33] * scale, s[7 * 33] * scale);
        *(u32x4*)(WT + (size_t)(drow + n) * Kd + k0 + 8 * c) = o; }
    asm volatile("s_waitcnt lgkmcnt(0)" ::: "memory");
}

#define OPAQUE_TID() int tid = threadIdx.x; asm volatile("" : "+v"(tid)); const int lane = tid & 63, wave = __builtin_amdgcn_readfirstlane(tid >> 6); (void)lane; (void)wave
__device__ __forceinline__ void phase0(const Args& a, LAS unsigned char* L) {
    OPAQUE_TID();
    const int bid = blockIdx.x, G = gridDim.x;
    float* modp = (float*)(a.ws + WS_MODP);
    for (int item = bid; item < 192; item += G) {
        const int cc = item >> 2, kq = item & 3;
        LAS float* sC = (LAS float*)L;
        {
            const int kk = tid & 255, rh = tid >> 8;
            float cp[8], cs[16];
            const float* p0 = a.in[2] + (size_t)rh * DM + kq * 256 + kk; const float* p1 = a.in[3] + (size_t)rh * DM + kq * 256 + kk;
#pragma unroll
            for (int n = 0; n < 8; ++n) cp[n] = p0[(size_t)(2 * n) * DM];
#pragma unroll
            for (int n = 0; n < 16; ++n) cs[n] = p1[(size_t)(2 * n) * DM];
#pragma unroll
            for (int n = 0; n < 8; ++n) sC[kk * 48 + rh + 2 * n] = cp[n] * sigmoidf_(cp[n]);
#pragma unroll
            for (int n = 0; n < 16; ++n) sC[kk * 48 + 16 + rh + 2 * n] = cs[n] * sigmoidf_(cs[n]);
        }
        __syncthreads();
        float acc[48];
#pragma unroll
        for (int r = 0; r < 48; ++r) acc[r] = 0.f;
        const float* wp = a.in[8] + (size_t)(kq * 256 + wave * 32) * 3072 + cc * 64 + lane;
#pragma unroll 16
        for (int i = 0; i < 32; ++i) {
            const float w = wp[(size_t)i * 3072];
            const LAS f32x4* s4 = (const LAS f32x4*)(sC + (wave * 32 + i) * 48);
#pragma unroll
            for (int r4 = 0; r4 < 12; ++r4) { const f32x4 s = s4[r4]; acc[4 * r4 + 0] += s[0] * w; acc[4 * r4 + 1] += s[1] * w; acc[4 * r4 + 2] += s[2] * w; acc[4 * r4 + 3] += s[3] * w; }
        }
        __syncthreads();
        LAS float* red = (LAS float*)L;
#pragma unroll
        for (int r = 0; r < 48; ++r) red[(wave * 48 + r) * 64 + lane] = acc[r];
        __syncthreads();
        for (int o = tid; o < 3072; o += 512) { float s = 0.f;
#pragma unroll
            for (int w8 = 0; w8 < 8; ++w8) s += red[w8 * 3072 + o];
            modp[(size_t)(kq * 48 + (o >> 6)) * 3072 + cc * 64 + (o & 63)] = s; }
        __syncthreads();
    }
    LAS float* scr = (LAS float*)(L + wave * 16384);
    bf16_t* Win = (bf16_t*)(a.ws + WS_WIN); bf16_t* Wout = (bf16_t*)(a.ws + WS_WOUT); bf16_t* Wpool = (bf16_t*)(a.ws + WS_WPOOL);
    const int gw = bid * 8 + wave, NGW = G * 8;
    constexpr int I_IN = 16 * 224, I_OUT = 32 * 32, I_POOL = 128;
    for (int it = gw; it < I_IN + I_OUT + I_POOL; it += NGW) {
        int r = it;
        if (r < I_IN) { const int kb = r / 224, nb = r - kb * 224, n0 = nb * 32, n = n0 + (lane & 31), sec = n0 >> 10;
            int scol;
            if (sec < 2) scol = n;
            else if (sec < 4) { const int d = n - 2048, q = d >> 3, rr = d & 7; scol = (rr < 4 ? 5120 : 6144) + 4 * q + (rr & 3); }
            else scol = n - 2048;
            transpose_item(a.in[11], WIN_LD, scol, Win, 1024, n0, kb * 64, sec == 5 ? 0.0625f : 1.f, scr, lane); continue; }
        r -= I_IN;
        if (r < I_OUT) { const int kb = r >> 5, nb = r & 31; transpose_item(a.in[17], 1024, nb * 32 + (lane & 31), Wout, 2048, nb * 32, kb * 64, 1.f, scr, lane); continue; }
        r -= I_OUT;
        { const int gi = r >> 5, q = r & 31, kb = q >> 3, nb = q & 7; transpose_item(a.in[14] + (size_t)gi * 65536, 256, nb * 32 + (lane & 31), Wpool, 256, gi * 256 + nb * 32, kb * 64, 1.f, scr, lane); }
    }
}

__device__ __forceinline__ void phase1(const Args& a, LAS unsigned char* L) {
    OPAQUE_TID();
    const int bid = blockIdx.x, G = gridDim.x;
    const float* modp = (const float*)(a.ws + WS_MODP); const float* bada = a.in[9];
    float* gatef = (float*)(a.ws + WS_GATEF); float* gates = (float*)(a.ws + WS_GATES);
    bf16_t* HB = (bf16_t*)a.out;
    for (int r = bid; r < 48; r += G)
        for (int c = tid; c < DM; c += 512) { float s = bada[2048 + c];
#pragma unroll
            for (int q = 0; q < 4; ++q) s += modp[(size_t)(q * 48 + r) * 3072 + 2048 + c];
            gatef[r * DM + c] = s; }
    LAS f32x4* wg = (LAS f32x4*)L;
    for (int e = tid; e < 2048; e += 512) { const int ln = e & 63, q = e >> 6, half = q & 1, ji = q >> 1, k = 4 * ln + 256 * (ji >> 2) + (ji & 3);
        wg[e] = *(const f32x4*)(a.in[11] + (size_t)k * WIN_LD + 7168 + half * 4); }
    __syncthreads();
    const int gw = bid * 8 + wave;
    constexpr int RPW = 17;
    int m_lo = gw * RPW, m_hi = m_lo + RPW; if (m_hi > MT) m_hi = MT;
    int curb = -1; f32x4 gsv[4], shv[4];
#pragma unroll
    for (int j = 0; j < 4; ++j) { gsv[j] = (f32x4){0.f, 0.f, 0.f, 0.f}; shv[j] = gsv[j]; }
    f32x4 nxv[4], nxw[4];
#pragma unroll
    for (int j = 0; j < 4; ++j) { nxv[j] = (f32x4){0.f, 0.f, 0.f, 0.f}; nxw[j] = nxv[j]; }
    if (m_lo < m_hi) { const float* xr = (m_lo < MP ? a.in[0] + (size_t)m_lo * DM : a.in[1] + (size_t)(m_lo - MP) * DM);
#pragma unroll
        for (int j = 0; j < 4; ++j) nxv[j] = *(const f32x4*)(xr + 4 * lane + 256 * j); }
    if (m_lo + 1 < m_hi) { const int m1 = m_lo + 1; const float* xr = (m1 < MP ? a.in[0] + (size_t)m1 * DM : a.in[1] + (size_t)(m1 - MP) * DM);
#pragma unroll
        for (int j = 0; j < 4; ++j) nxw[j] = *(const f32x4*)(xr + 4 * lane + 256 * j); }
    for (int m = m_lo; m < m_hi; ++m) {
        const int b = m < MP ? (m >> 11) : 16 + ((m - MP) >> 5);
        if (b != curb) { curb = b;
#pragma unroll
            for (int j = 0; j < 4; ++j) { const int col = 4 * lane + 256 * j;
                f32x4 sh = *(const f32x4*)(bada + col), sc = *(const f32x4*)(bada + 1024 + col);
#pragma unroll
                for (int q = 0; q < 4; ++q) { sh += *(const f32x4*)(modp + (size_t)(q * 48 + b) * 3072 + col); sc += *(const f32x4*)(modp + (size_t)(q * 48 + b) * 3072 + 1024 + col); }
                const f32x4 gn = *(const f32x4*)(a.in[10] + col);
                gsv[j] = gn * (sc + 1.f); shv[j] = sh; } }
        f32x4 v[4]; float ss = 0.f;
#pragma unroll
        for (int j = 0; j < 4; ++j) { v[j] = nxv[j]; nxv[j] = nxw[j]; }
        if (m + 2 < m_hi) { const int m1 = m + 2; const float* xr = (m1 < MP ? a.in[0] + (size_t)m1 * DM : a.in[1] + (size_t)(m1 - MP) * DM);
#pragma unroll
            for (int j = 0; j < 4; ++j) nxw[j] = *(const f32x4*)(xr + 4 * lane + 256 * j); }
#pragma unroll
        for (int j = 0; j < 4; ++j) ss += (v[j][0] * v[j][0] + v[j][1] * v[j][1]) + (v[j][2] * v[j][2] + v[j][3] * v[j][3]);
        const float rr = rsqrtf(wave_sum(ss) * (1.f / DM) + EPS);
        float gacc[8];
#pragma unroll
        for (int q = 0; q < 8; ++q) gacc[q] = 0.f;
#pragma unroll
        for (int j = 0; j < 4; ++j) { const f32x4 h = v[j] * rr * gsv[j] + shv[j];
            *(u32x2*)(HB + (size_t)m * DM + 4 * lane + 256 * j) = (u32x2){pk2(h[0], h[1]), pk2(h[2], h[3])};
#pragma unroll
            for (int i = 0; i < 4; ++i) { const f32x4 w0 = wg[((j * 4 + i) * 2) * 64 + lane], w1 = wg[((j * 4 + i) * 2 + 1) * 64 + lane];
                gacc[0] += h[i] * w0[0]; gacc[1] += h[i] * w0[1]; gacc[2] += h[i] * w0[2]; gacc[3] += h[i] * w0[3];
                gacc[4] += h[i] * w1[0]; gacc[5] += h[i] * w1[1]; gacc[6] += h[i] * w1[2]; gacc[7] += h[i] * w1[3]; } }
#pragma unroll
        for (int q = 0; q < 8; ++q) gacc[q] = wave_sum(gacc[q]);
        if (lane == 0) { *(f32x4*)(gates + (size_t)m * 8) = (f32x4){gacc[0], gacc[1], gacc[2], gacc[3]}; *(f32x4*)(gates + (size_t)m * 8 + 4) = (f32x4){gacc[4], gacc[5], gacc[6], gacc[7]}; }
    }
    __syncthreads();
}

constexpr int L_QS = 0, L_KS = 16896, L_VT = 33792, L_VTW = 40192, L_SS = 46592, L_CS = 49152;
constexpr int L_GFM = 91392, L_GAA = L_GFM + 8192, L_GEN = L_GAA + 8192, L_GWL = L_GEN + 8192, L_GM0 = L_GWL + 8192, L_GDL = L_GM0 + 256, L_GX = L_GDL + 256, L_NQ = L_GX + 256;
static_assert(L_NQ + 512 <= 131072, "LDS map");
#define LDS_BARRIER() do { asm volatile("s_waitcnt lgkmcnt(0)" ::: "memory"); __builtin_amdgcn_s_barrier(); asm volatile("" ::: "memory"); } while (0)
__device__ __forceinline__ float dpp_shr_f(float oldv, float src, int d) {
    int r;
    switch (d) {
        case 1: r = __builtin_amdgcn_update_dpp(__float_as_int(oldv), __float_as_int(src), 0x111, 0xf, 0xf, false); break;
        case 2: r = __builtin_amdgcn_update_dpp(__float_as_int(oldv), __float_as_int(src), 0x112, 0xf, 0xf, false); break;
        case 4: r = __builtin_amdgcn_update_dpp(__float_as_int(oldv), __float_as_int(src), 0x114, 0xf, 0xf, false); break;
        default: r = __builtin_amdgcn_update_dpp(__float_as_int(oldv), __float_as_int(src), 0x118, 0xf, 0xf, false); break;
    }
    return __int_as_float(r);
}
__device__ __forceinline__ void mlstm_item(const Args& a, LAS unsigned char* L, bool sample, int b, int hh, int sl, bool dry = false) {
    OPAQUE_TID();
    bf16_t* U = (bf16_t*)(a.ws + WS_U);
    const float* gates = (const float*)(a.ws + WS_GATES);
    const int g = lane >> 4, lr = lane & 15, t32 = lane & 31;
    const int rowbase = sample ? MP + b * SSEQ : b * SEQ;
    const int nchunks = sample ? 1 : SEQ / 32;
    const float bi = a.in[12][hh], bfv = a.in[13][hh];
    LAS float* GFM = (LAS float*)(L + L_GFM); LAS float* GAA = (LAS float*)(L + L_GAA); LAS float* GEN = (LAS float*)(L + L_GEN); LAS float* GWL = (LAS float*)(L + L_GWL);
    LAS float* GM0 = (LAS float*)(L + L_GM0); LAS float* GDL = (LAS float*)(L + L_GDL); LAS float* GX = (LAS float*)(L + L_GX);
    { const int row = 64 + (tid >> 5), s = tid & 31;
      *(LAS bf16_t*)(L + L_VT + row * 80 + s * 2) = (row == 64) ? (bf16_t)0x3F80 : (bf16_t)0;
      *(LAS bf16_t*)(L + L_VTW + row * 80 + s * 2) = (bf16_t)0; }
    f32x4 Cacc[2][5];
#pragma unroll
    for (int kti = 0; kti < 2; ++kti)
#pragma unroll
        for (int vt = 0; vt < 5; ++vt) Cacc[kti][vt] = (f32x4){0.f, 0.f, 0.f, 0.f};
    float m_init = 0.f;
    if (sample) {
        const float* sC = a.in[5] + (size_t)(b * 4 + hh) * 65536; const float* sn = a.in[6] + (size_t)(b * 4 + hh) * 256;
#pragma unroll
        for (int kti = 0; kti < 2; ++kti)
#pragma unroll
            for (int j = 0; j < 4; ++j) { const int k = (2 * wave + kti) * 16 + g * 4 + j;
#pragma unroll
                for (int vt = 0; vt < 4; ++vt) Cacc[kti][vt][j] = sC[(size_t)k * 256 + sl * 64 + vt * 16 + lr];
                Cacc[kti][4][j] = (lr == 0) ? sn[k] : 0.f; }
        m_init = a.in[7][b * 4 + hh];
    }
#define WRITE_CS() do { _Pragma("unroll") for (int kti = 0; kti < 2; ++kti) _Pragma("unroll") for (int vt = 0; vt < 5; ++vt) \
        *(LAS u32x2*)(L + L_CS + (vt * 16 + lr) * 528 + ((2 * wave + kti) * 16 + g * 4) * 2) = (u32x2){pk2(Cacc[kti][vt][0], Cacc[kti][vt][1]), pk2(Cacc[kti][vt][2], Cacc[kti][vt][3])}; } while (0)
    WRITE_CS();
    u32x4 qreg[2], kreg[2]; u32x2 vreg0 = (u32x2){0u, 0u}, vreg1 = vreg0;
    const int prow = tid >> 5, pcc = tid & 31;
    const int sp = tid & 15, vq = tid >> 4;
#define PREFETCH(c) do { const size_t r0 = (size_t)(rowbase + (c) * 32); \
        _Pragma("unroll") for (int i = 0; i < 2; ++i) { const bf16_t* p = U + (r0 + prow + 16 * i) * LDU + hh * 256 + pcc * 8; qreg[i] = *(const u32x4*)(p + C_Q); kreg[i] = *(const u32x4*)(p + C_K); } \
        if (tid < 256) { const bf16_t* pv = U + (r0 + 2 * sp) * LDU + C_V + hh * 256 + sl * 64 + vq * 4; vreg0 = *(const u32x2*)pv; vreg1 = *(const u32x2*)(pv + LDU); } } while (0)
    PREFETCH(0);
    for (int c = wave; c < nchunks; c += 8) {
        const size_t r0 = (size_t)(rowbase + c * 32 + t32);
        const float ig = gates[r0 * 8 + hh] + bi, xg = gates[r0 * 8 + 4 + hh] + bfv;
        const float lf = fminf(xg, 0.f) - log1pf(__expf(-fabsf(xg)));
        float F = lf;
        F += dpp_shr_f(0.f, F, 1); F += dpp_shr_f(0.f, F, 2); F += dpp_shr_f(0.f, F, 4); F += dpp_shr_f(0.f, F, 8);
        { const float r15 = __int_as_float(__builtin_amdgcn_readlane(__float_as_int(F), 15)); if (lane & 16) F += r15; }
        const float aa = ig - F;
        const float NINF = -__builtin_inff();
        float cm = aa;
        cm = fmaxf(cm, dpp_shr_f(NINF, cm, 1)); cm = fmaxf(cm, dpp_shr_f(NINF, cm, 2)); cm = fmaxf(cm, dpp_shr_f(NINF, cm, 4)); cm = fmaxf(cm, dpp_shr_f(NINF, cm, 8));
        { const float r15 = __int_as_float(__builtin_amdgcn_readlane(__float_as_int(cm), 15)); if (lane & 16) cm = fmaxf(cm, r15); }
        if (lane < 32) { GAA[c * 32 + lane] = aa; GFM[c * 32 + lane] = cm; GEN[c * 32 + lane] = F; }
        if (lane == 31) { GDL[c] = F; GM0[c] = cm; }
    }
    LDS_BARRIER();
    float m_fin;
    {
        const bool act = lane < nchunks;
        const float FLc = act ? GDL[lane] : 0.f, aLc = act ? GM0[lane] : -__builtin_inff();
        float mrun = m_init, my_m0 = m_init; m_fin = m_init;
#pragma unroll
        for (int c = 0; c < 64; ++c) {
            const float fl = __int_as_float(__builtin_amdgcn_readlane(__float_as_int(FLc), c)), al = __int_as_float(__builtin_amdgcn_readlane(__float_as_int(aLc), c));
            if (lane == c) my_m0 = mrun;
            mrun = fl + fmaxf(mrun, al);
            if (c + 1 == nchunks) m_fin = mrun;
        }
        LDS_BARRIER();
        if (wave == 0 && act) { const float mLc = FLc + fmaxf(my_m0, aLc); GM0[lane] = my_m0; GDL[lane] = __expf(my_m0 + FLc - mLc); GX[lane] = FLc - mLc; }
    }
    LDS_BARRIER();
    for (int idx = tid; idx < nchunks * 32; idx += 512) { const int c = idx >> 5; const float m0c = GM0[c], cm = GFM[idx], F = GEN[idx], aa = GAA[idx], mm = fmaxf(m0c, cm);
        GFM[idx] = -mm; GEN[idx] = __expf(-(F + mm)); GWL[idx] = __expf(aa + GX[c]); }
    LDS_BARRIER();
    for (int c = 0; c < nchunks; ++c) {
#pragma unroll
        for (int i = 0; i < 2; ++i) { *(LAS u32x4*)(L + L_QS + (prow + 16 * i) * 528 + pcc * 16) = qreg[i]; *(LAS u32x4*)(L + L_KS + (prow + 16 * i) * 528 + pcc * 16) = kreg[i]; }
        if (tid < 256) {
            const float wL0 = GWL[c * 32 + 2 * sp], wL1 = GWL[c * 32 + 2 * sp + 1];
            const unsigned r0w[2] = {vreg0.x, vreg0.y}, r1w[2] = {vreg1.x, vreg1.y};
#pragma unroll
            for (int i = 0; i < 4; ++i) { const unsigned e0 = (i & 1) ? (r0w[i >> 1] >> 16) : (r0w[i >> 1] & 0xffffu), e1 = (i & 1) ? (r1w[i >> 1] >> 16) : (r1w[i >> 1] & 0xffffu);
                *(LAS unsigned*)(L + L_VT + (vq * 4 + i) * 80 + sp * 4) = e0 | (e1 << 16);
                *(LAS unsigned*)(L + L_VTW + (vq * 4 + i) * 80 + sp * 4) = pk2(bf2f(e0) * wL0, bf2f(e1) * wL1); }
            if (tid < 16) *(LAS unsigned*)(L + L_VTW + 64 * 80 + sp * 4) = pk2(wL0, wL1);
        }
        if (c + 1 < nchunks) PREFETCH(c + 1);
        LDS_BARRIER();
        const float dL = GDL[c], m0c = GM0[c];
        if (wave < 4) {
            const int st = wave >> 1, tt = wave & 1, t = tt * 16 + lr;
            f32x4 s = (f32x4){0.f, 0.f, 0.f, 0.f};
            if (!(st == 1 && tt == 0)) {
                bf16x8 Af[8], Bf[8];
#pragma unroll
                for (int kk = 0; kk < 8; ++kk) { Af[kk] = *(const LAS bf16x8*)(L + L_KS + (st * 16 + lr) * 528 + kk * 64 + g * 16); Bf[kk] = *(const LAS bf16x8*)(L + L_QS + t * 528 + kk * 64 + g * 16); }
                __builtin_amdgcn_sched_barrier(0);
#pragma unroll
                for (int kk = 0; kk < 8; ++kk) s = MFMA16(Af[kk], Bf[kk], s);
            }
            const float fmt = GFM[c * 32 + t];
            const f32x4 as4 = *(const LAS f32x4*)(L + L_GAA + (c * 32 + st * 16 + g * 4) * 4);
            float val[4];
#pragma unroll
            for (int j = 0; j < 4; ++j) { const int si = st * 16 + g * 4 + j; const float e = __expf(fminf(fmt + as4[j], 0.f)); val[j] = (si <= t) ? s[j] * e : 0.f; }
            *(LAS u32x2*)(L + L_SS + t * 80 + (st * 16 + g * 4) * 2) = (u32x2){pk2(val[0], val[1]), pk2(val[2], val[3])};
            float rsum = (val[0] + val[1]) + (val[2] + val[3]);
            rsum += __shfl_xor(rsum, 16); rsum += __shfl_xor(rsum, 32);
            if (g == 0) *(LAS float*)(L + L_NQ + (st * 32 + t) * 4) = rsum;
        } else {
            const int w4 = wave - 4, tt = w4 & 1, kh = w4 >> 1, t = tt * 16 + lr;
            f32x4 cA = (f32x4){0.f, 0.f, 0.f, 0.f};
            bf16x8 Af[4], Bf[4];
#pragma unroll
            for (int kk = 0; kk < 4; ++kk) { const int ko = (kh * 4 + kk) * 64 + g * 16; Af[kk] = *(const LAS bf16x8*)(L + L_CS + (64 + lr) * 528 + ko); Bf[kk] = *(const LAS bf16x8*)(L + L_QS + t * 528 + ko); }
            __builtin_amdgcn_sched_barrier(0);
#pragma unroll
            for (int kk = 0; kk < 4; ++kk) cA = MFMA16(Af[kk], Bf[kk], cA);
            if (g == 0) *(LAS float*)(L + L_NQ + (64 + kh * 32 + t) * 4) = cA[0];
        }
        {
            typedef short v4i16_t __attribute__((ext_vector_type(4)));
            v4i16_t tl[2], th[2]; bf16x8 Bv[5];
#pragma unroll
            for (int kti = 0; kti < 2; ++kti) { const int kt = 2 * wave + kti;
                tl[kti] = __builtin_amdgcn_ds_read_tr16_b64_v4i16((LAS v4i16_t*)(L + L_KS + (g * 8 + (lr >> 2)) * 528 + (kt * 16 + 4 * (lr & 3)) * 2));
                th[kti] = __builtin_amdgcn_ds_read_tr16_b64_v4i16((LAS v4i16_t*)(L + L_KS + (g * 8 + 4 + (lr >> 2)) * 528 + (kt * 16 + 4 * (lr & 3)) * 2)); }
#pragma unroll
            for (int vt = 0; vt < 5; ++vt) Bv[vt] = *(const LAS bf16x8*)(L + L_VTW + (vt * 16 + lr) * 80 + g * 16);
#pragma unroll
            for (int kti = 0; kti < 2; ++kti) { const bf16x8 A = (bf16x8){tl[kti][0], tl[kti][1], tl[kti][2], tl[kti][3], th[kti][0], th[kti][1], th[kti][2], th[kti][3]};
#pragma unroll
                for (int vt = 0; vt < 5; ++vt) Cacc[kti][vt] = MFMA16(A, Bv[vt], Cacc[kti][vt] * dL); }
        }
        LDS_BARRIER();
        {
            const int tt = wave & 1, vt = wave >> 1, t = tt * 16 + lr;
            const bf16x8 Bs = *(const LAS bf16x8*)(L + L_SS + t * 80 + g * 16);
            const f32x4 z4 = (f32x4){0.f, 0.f, 0.f, 0.f};
            const bf16x8 Av = *(const LAS bf16x8*)(L + L_VT + (vt * 16 + lr) * 80 + g * 16);
            bf16x8 Af[8], Bf[8];
#pragma unroll
            for (int kk = 0; kk < 8; ++kk) { Af[kk] = *(const LAS bf16x8*)(L + L_CS + (vt * 16 + lr) * 528 + kk * 64 + g * 16); Bf[kk] = *(const LAS bf16x8*)(L + L_QS + t * 528 + kk * 64 + g * 16); }
            __builtin_amdgcn_sched_barrier(0);
            f32x4 sM = MFMA16(Av, Bs, z4);
            f32x4 cM = z4;
#pragma unroll
            for (int kk = 0; kk < 8; ++kk) cM = MFMA16(Af[kk], Bf[kk], cM);
            const float d0 = __expf(m0c + GFM[c * 32 + t]), en = GEN[c * 32 + t];
            const LAS float* NQ = (const LAS float*)(L + L_NQ);
            const float nq = (NQ[t] + NQ[32 + t]) + d0 * (NQ[64 + t] + NQ[96 + t]);
            const float inv = __builtin_amdgcn_rcpf(fmaxf(fabsf(nq), en));
            float hv[4];
#pragma unroll
            for (int j = 0; j < 4; ++j) hv[j] = (sM[j] + d0 * cM[j]) * inv;
            if (dry) *(u32x2*)((bf16_t*)a.out + (size_t)(rowbase + c * 32 + t) * 1024 + hh * 256 + sl * 64 + vt * 16 + g * 4) = (u32x2){pk2(hv[0], hv[1]), pk2(hv[2], hv[3])};
            else *(u32x2*)(U + (size_t)(rowbase + c * 32 + t) * LDU + C_V + hh * 256 + sl * 64 + vt * 16 + g * 4) = (u32x2){pk2(hv[0], hv[1]), pk2(hv[2], hv[3])};
        }
        LDS_BARRIER();
        WRITE_CS();
    }
    {
        float* oC = a.out + (sample ? O_CS : O_CP) + (size_t)(b * 4 + hh) * 65536;
#pragma unroll
        for (int kti = 0; kti < 2; ++kti)
#pragma unroll
            for (int j = 0; j < 4; ++j) { const int k = (2 * wave + kti) * 16 + g * 4 + j;
#pragma unroll
                for (int vt = 0; vt < 4; ++vt) oC[(size_t)k * 256 + sl * 64 + vt * 16 + lr] = Cacc[kti][vt][j];
                if (sl == 0 && lr == 0) a.out[(sample ? O_NS : O_NP) + (size_t)(b * 4 + hh) * 256 + k] = Cacc[kti][4][j]; }
        if (sl == 0 && tid == 0) a.out[(sample ? O_MS : O_MP) + b * 4 + hh] = m_fin;
    }
    LDS_BARRIER();
#undef WRITE_CS
#undef PREFETCH
}

template <int W>
__device__ __forceinline__ void pool_run(const Args& a, const bf16_t* U, bf16_t* PB, int row0, int ch) {
    const bool sample = row0 >= MP;
    const int b = sample ? (row0 - MP) >> 5 : row0 >> 11, t0 = sample ? (row0 - MP) & 31 : row0 & 2047, T = sample ? SSEQ : SEQ, seqbase = row0 - t0;
    constexpr int NR = W + 15;
    u32x4 rows[NR];
#pragma unroll
    for (int r = 0; r < NR; ++r) {
        const int t = t0 - (W - 1) + r;
        if (t >= 0) rows[r] = *(const u32x4*)(U + (size_t)(seqbase + t) * LDU + C_XP + ch);
        else if (sample) { const float* p = a.in[4] + (size_t)(b * 15 + 15 + t) * 1024 + ch; const f32x4 p0 = *(const f32x4*)p, p1 = *(const f32x4*)(p + 4);
            rows[r] = (u32x4){pk2(p0[0], p0[1]), pk2(p0[2], p0[3]), pk2(p1[0], p1[1]), pk2(p1[2], p1[3])}; }
        else rows[r] = (u32x4){0u, 0u, 0u, 0u};
    }
    float sum[8], cur[8], old[8];
#pragma unroll
    for (int i = 0; i < 8; ++i) sum[i] = 0.f;
#pragma unroll
    for (int r = 0; r < W - 1; ++r) { unpack8(rows[r], old);
#pragma unroll
        for (int i = 0; i < 8; ++i) sum[i] += old[i]; }
#pragma unroll
    for (int i16 = 0; i16 < 16; ++i16) {
        const int t = t0 + i16;
        unpack8(rows[W - 1 + i16], cur); unpack8(rows[i16], old);
        const int cnt = sample ? W : ((t + 1 < W) ? t + 1 : W);
        const float ic = __builtin_amdgcn_rcpf((float)cnt);
        float p[8];
#pragma unroll
        for (int i = 0; i < 8; ++i) { sum[i] += cur[i]; p[i] = sum[i] * ic - cur[i]; sum[i] -= old[i]; }
        *(u32x4*)(PB + (size_t)(row0 + i16) * 1024 + ch) = (u32x4){pk2(p[0], p[1]), pk2(p[2], p[3]), pk2(p[4], p[5]), pk2(p[6], p[7])};
        if (t >= T - 15) { float* op = a.out + (sample ? O_PS : O_PP) + (size_t)(b * 15 + t - (T - 15)) * 1024 + ch;
            *(f32x4*)op = (f32x4){cur[0], cur[1], cur[2], cur[3]}; *(f32x4*)(op + 4) = (f32x4){cur[4], cur[5], cur[6], cur[7]}; }
    }
}
__device__ __forceinline__ void pool_prepass(const Args& a) {
    OPAQUE_TID();
    const bf16_t* U = (const bf16_t*)(a.ws + WS_U);
    bf16_t* PB = (bf16_t*)a.out;
    const int G = gridDim.x, gq = wave & 3, ch = gq * 256 + (lane & 31) * 8;
    for (int it = blockIdx.x; it < MT / 64; it += G) {
        const int row0 = (it * 4 + (wave >> 2) * 2 + (lane >> 5)) * 16;
        if (gq == 0) pool_run<2>(a, U, PB, row0, ch);
        else if (gq == 1) pool_run<4>(a, U, PB, row0, ch);
        else if (gq == 2) pool_run<8>(a, U, PB, row0, ch);
        else pool_run<16>(a, U, PB, row0, ch);
    }
}

__device__ __forceinline__ float half_sum(float v) {
#pragma unroll
    for (int o = 1; o < 32; o <<= 1) v += __shfl_xor(v, o);
    return v;
}
__device__ __forceinline__ void ym_finalize(const Args& a, bool dry = false) {
    OPAQUE_TID();
    bf16_t* U = (bf16_t*)(a.ws + WS_U);
    const int gw = blockIdx.x * 8 + wave, NGW = gridDim.x * 8;
    const int cbase = (lane >> 5) * 256 + 8 * (lane & 31);
    f32x4 gh[2][2];
#pragma unroll
    for (int hp = 0; hp < 2; ++hp) { gh[hp][0] = *(const f32x4*)(a.in[16] + cbase + 512 * hp); gh[hp][1] = *(const f32x4*)(a.in[16] + cbase + 512 * hp + 4); }
    u32x4 nh[2], nz[2];
#define YM_LOAD(row) do { const bf16_t* ur_ = U + (size_t)(row) * LDU + cbase; _Pragma("unroll") for (int hp = 0; hp < 2; ++hp) { \
        nh[hp] = *(const u32x4*)(ur_ + C_V + 512 * hp); nz[hp] = *(const u32x4*)(ur_ + C_ZM + 512 * hp); } } while (0)
    if (gw < MT) YM_LOAD(gw);
    for (int row = gw; row < MT; row += NGW) {
        u32x4 ch[2], cz[2];
#pragma unroll
        for (int hp = 0; hp < 2; ++hp) { ch[hp] = nh[hp]; cz[hp] = nz[hp]; }
        if (row + NGW < MT) YM_LOAD(row + NGW);
#pragma unroll
        for (int hp = 0; hp < 2; ++hp) {
            float x[8], z[8];
            unpack8(ch[hp], x); unpack8(cz[hp], z);
            float sm = 0.f;
#pragma unroll
            for (int i = 0; i < 8; ++i) sm += x[i];
            const float mu = half_sum(sm) * (1.f / 256.f);
            float q = 0.f;
#pragma unroll
            for (int i = 0; i < 8; ++i) { x[i] -= mu; q += x[i] * x[i]; }
            const float rs = rsqrtf(half_sum(q) * (1.f / 256.f) + EPS);
            float y[8];
#pragma unroll
            for (int i = 0; i < 8; ++i) y[i] = x[i] * rs * gh[hp][i >> 2][i & 3] * z[i];
            bf16_t* dst_ = dry ? (bf16_t*)a.out + (size_t)MT * 1024 + (size_t)row * 1024 + cbase + 512 * hp : U + (size_t)row * LDU + cbase + C_ZM + 512 * hp;
            *(u32x4*)dst_ = (u32x4){pk2(y[0], y[1]), pk2(y[2], y[3]), pk2(y[4], y[5]), pk2(y[6], y[7])};
        }
    }
#undef YM_LOAD
}

__device__ __forceinline__ void sample_finalize(const Args& a) {
    OPAQUE_TID();
    const int gw = blockIdx.x * 8 + wave, NGW = gridDim.x * 8;
    const float* part = (const float*)(a.ws + WS_PART); const float* gatef = (const float*)(a.ws + WS_GATEF);
    for (int r = gw; r < MS; r += NGW) {
        f32x4 v[4]; float ss = 0.f;
#pragma unroll
        for (int j = 0; j < 4; ++j) { const int col = 4 * lane + 256 * j;
            f32x4 p = *(const f32x4*)(part + (size_t)r * DM + col);
#pragma unroll
            for (int ks = 1; ks < 4; ++ks) p += *(const f32x4*)(part + ((size_t)ks * MS + r) * DM + col);
            v[j] = *(const f32x4*)(a.in[1] + (size_t)r * DM + col) + *(const f32x4*)(gatef + (16 + (r >> 5)) * DM + col) * p;
            ss += (v[j][0] * v[j][0] + v[j][1] * v[j][1]) + (v[j][2] * v[j][2] + v[j][3] * v[j][3]); }
        const float rr = rsqrtf(wave_sum(ss) * (1.f / DM) + EPS);
#pragma unroll
        for (int j = 0; j < 4; ++j) { const int col = 4 * lane + 256 * j; *(f32x4*)(a.out + (size_t)(MP + r) * DM + col) = v[j] * rr * *(const f32x4*)(a.in[18] + col); }
    }
}

#define XB_TMO      128
#define XB_XCNT(j)  (256  + 64 * (j))
#define XB_XSUB(j)  (1280 + 64 * (j))
#define XB_XGEN(j)  (2304 + 64 * (j))
#define XB_TOP      3328
#define XB_TOPGEN   3392
#define XCD_BAR_WORDS 3456
#define XB_SPIN_CAP (1u << 18)
__device__ __forceinline__ unsigned xb_ld(unsigned* p)              { return __hip_atomic_load(p, __ATOMIC_RELAXED, __HIP_MEMORY_SCOPE_AGENT); }
__device__ __forceinline__ unsigned xb_add(unsigned* p, unsigned v) { return __hip_atomic_fetch_add(p, v, __ATOMIC_RELAXED, __HIP_MEMORY_SCOPE_AGENT); }
__device__ __forceinline__ unsigned xb_xcc_id() { return (unsigned)__builtin_amdgcn_s_getreg((3 << 11) | 20) & 0xFu; }
#define XB_SPIN(cond, bar) do { unsigned _sp = 0; while (cond) { __builtin_amdgcn_s_sleep(1); \
    if ((++_sp & 255u) == 0u) { if (xb_ld(&(bar)[XB_TMO])) break; if (_sp > XB_SPIN_CAP) { atomicAdd(&(bar)[XB_TMO], 1u); break; } } } } while (0)
struct XcdBarrier { unsigned* bar; unsigned x; volatile LAS unsigned* st; };
__device__ __forceinline__ XcdBarrier xcd_barrier_post(unsigned* bar, volatile LAS unsigned* st) {
    XcdBarrier b; b.bar = bar; b.x = xb_xcc_id(); b.st = st;
    if (threadIdx.x == 0) (void)xb_add(&bar[XB_XCNT(b.x)], 1u);
    return b;
}
__device__ __forceinline__ void xcd_barrier_complete(unsigned* bar, unsigned x, unsigned& nloc, unsigned& nx) {
    const unsigned G = gridDim.x * gridDim.y * gridDim.z;
    unsigned sum, cnt, mine, sp = 0u;
    for (;;) {
        sum = 0u; cnt = 0u; mine = 0u;
#pragma unroll
        for (unsigned j = 0; j < 16; ++j) { const unsigned c = xb_ld(&bar[XB_XCNT(j)]); sum += c; cnt += (c > 0u) ? 1u : 0u; mine = (j == x) ? c : mine; }
        if (sum == G) break;
        __builtin_amdgcn_s_sleep(1);
        if ((++sp & 255u) == 0u) { if (xb_ld(&bar[XB_TMO])) break; if (sp > XB_SPIN_CAP) { atomicAdd(&bar[XB_TMO], 1u); break; } }
    }
    nloc = mine > 0u ? mine : 1u; nx = cnt > 0u ? cnt : 1u;
}
__device__ __forceinline__ void xcd_barrier(const XcdBarrier& b) {
    asm volatile("s_waitcnt vmcnt(0)" ::: "memory");
    __syncthreads();
    if (threadIdx.x == 0) {
        unsigned* bar = b.bar;
        __builtin_amdgcn_s_waitcnt(0);
        unsigned nloc = b.st[0], nx = b.st[1];
        if (nloc == 0u) { xcd_barrier_complete(bar, b.x, nloc, nx); b.st[0] = nloc; b.st[1] = nx; }
        const unsigned old = xb_add(&bar[XB_XSUB(b.x)], 1u);
        const unsigned gen = old / nloc;
        if (old + 1u == (gen + 1u) * nloc) {
            __builtin_amdgcn_fence(__ATOMIC_RELEASE, "agent");
            asm volatile("s_waitcnt vmcnt(0)" ::: "memory");
            const unsigned og = xb_add(&bar[XB_TOP], 1u);
            const unsigned tg = og / nx;
            if (og + 1u == (tg + 1u) * nx) xb_add(&bar[XB_TOPGEN], 1u);
            else XB_SPIN(xb_ld(&bar[XB_TOPGEN]) == tg, bar);
            __builtin_amdgcn_fence(__ATOMIC_ACQUIRE, "agent");
            xb_add(&bar[XB_XGEN(b.x)], 1u);
            asm volatile("s_waitcnt vmcnt(0)" ::: "memory");
        } else {
            XB_SPIN(xb_ld(&bar[XB_XGEN(b.x)]) == gen, bar);
            __builtin_amdgcn_fence(__ATOMIC_ACQUIRE, "agent");
            asm volatile("s_waitcnt vmcnt(0)" ::: "memory");
        }
    }
    __syncthreads();
}

__global__ void __launch_bounds__(512, 2) fwd_megakernel(Args a) {
    extern __shared__ __attribute__((aligned(16))) unsigned char lds_raw[];
    LAS unsigned char* L = (LAS unsigned char*)lds_raw;
    cg::grid_group grid = cg::this_grid();
    const int bid = blockIdx.x, G = gridDim.x;
    bf16_t* U = (bf16_t*)(a.ws + WS_U);
    if (threadIdx.x < 4) ((LAS unsigned*)(L + L_MISC))[threadIdx.x] = 0u;
    __syncthreads();
    const XcdBarrier xbar = xcd_barrier_post((unsigned*)(a.ws + WS_CTL), (volatile LAS unsigned*)(L + L_MISC));

    phase0(a, L);
    if (a.out == nullptr) grid.sync();
    xcd_barrier(xbar);
    phase1(a, L);
    xcd_barrier(xbar);
    {
        pg8::Gemm g{(const bf16_t*)a.out, (const bf16_t*)(a.ws + WS_WIN), MT, LDU, 1024, 1024, 1024, 0};
        pg8::StaticOrder S; S.init(MT, LDU, G, bid);
        pg8::EpiBf16 E{U, LDU, 8, 16, 4, 8};
        pg8::gemm_phase<pg8::EpiBf16, pg8::StaticOrder, true, true>(L, g, S, E);
    }
    xcd_barrier(xbar);
    {
        if ((bid >> 3) & 1) pool_prepass(a);
        for (int it = bid; it < 256; it += G) { const int x = it & 7, loc = it >> 3, bh = x * 8 + (loc >> 2); mlstm_item(a, L, false, bh >> 2, bh & 3, loc & 3); }
        for (int it = bid; it < 512; it += G) { const int x = it & 7, loc = it >> 3, bh = x * 16 + (loc >> 2); mlstm_item(a, L, true, bh >> 2, bh & 3, loc & 3); }
        if (!((bid >> 3) & 1)) pool_prepass(a);
    }
    xcd_barrier(xbar);
    {
        pg8::Gemm g{(const bf16_t*)a.out, (const bf16_t*)(a.ws + WS_WPOOL), MT, 1024, 256, 1024, 256, 256};
        pg8::StaticOrder S; S.init(MT, 1024, G, bid, 256);
        pg8::EpiPool E{U, a.in[15], nullptr};
        if ((bid >> 3) & 1) ym_finalize(a);
        pg8::gemm_phase<pg8::EpiPool, pg8::StaticOrder, true, true>(L, g, S, E);
        if (!((bid >> 3) & 1)) ym_finalize(a);
    }
    xcd_barrier(xbar);
    {
        pg8::Gemm g{U + C_ZP, (const bf16_t*)(a.ws + WS_WOUT), MP, 1024, 2048, LDU, 2048, 0};
        pg8::PanelOrder S{bid};
        pg8::EpiResLN E{a.in[0], (const float*)(a.ws + WS_GATEF), a.in[18], a.out, (float*)(a.ws + WS_XBUF), (unsigned*)(a.ws + WS_CTL) + 4096};
        pg8::gemm_phase<pg8::EpiResLN, pg8::PanelOrder, true, true>(L, g, S, E);
        pg8::Gemm g2{U + C_ZP, (const bf16_t*)(a.ws + WS_WOUT), MT, 1024, 512, LDU, 2048, 0};
        pg8::SampleOrder S2{bid};
        pg8::EpiPart E2{(float*)(a.ws + WS_PART)};
        pg8::gemm_phase<pg8::EpiPart, pg8::SampleOrder, true, true>(L, g2, S2, E2);
    }
    xcd_barrier(xbar);
    sample_finalize(a);
}

extern "C" void kernel_launch(void* const* d_in, const int* in_sizes, int n_in, void* d_out, int out_size, void* d_ws, size_t ws_size, hipStream_t stream) {
    static int grid = 0;
    if (grid == 0) {
        if (n_in != 19 || ws_size < WS_END) { fprintf(stderr, "kernel_launch: unexpected inputs (n_in %d, ws %zu)\n", n_in, ws_size); grid = -1; return; }
        int dev = 0, cus = 0, per_cu = 0;
        hipGetDevice(&dev);
        hipDeviceGetAttribute(&cus, hipDeviceAttributeMultiprocessorCount, dev);
        hipFuncSetAttribute((const void*)fwd_megakernel, hipFuncAttributeMaxDynamicSharedMemorySize, LDS_BYTES);
        hipOccupancyMaxActiveBlocksPerMultiprocessor(&per_cu, (const void*)fwd_megakernel, 512, LDS_BYTES);
        if (per_cu < 1) per_cu = 1;
        (void)hipGetLastError();
        grid = cus * per_cu;
        if (grid != 256) { fprintf(stderr, "kernel_launch: this kernel needs exactly 256 co-resident workgroups (got %d)\n", grid); grid = -1; return; }
    }
    if (grid < 0) return;
    (void)hipMemsetAsync((char*)d_ws + WS_CTL, 0, 32768, stream);
    Args a{};
    for (int i = 0; i < 19; ++i) a.in[i] = (const float*)d_in[i];
    a.out = (float*)d_out; a.ws = (unsigned char*)d_ws;
    void* args[] = {&a};
    hipError_t e = hipLaunchCooperativeKernel((const void*)fwd_megakernel, dim3(grid), dim3(512), args, LDS_BYTES, stream);
    if (e != hipSuccess) fprintf(stderr, "cooperative launch failed: %s (grid %d)\n", hipGetErrorString(e), grid);
}
```
